# Optimizing an MI355X kernel written in HIP

```python
import jax, jax.numpy as jnp
from jax import lax
import numpy as np

D_MODEL = 1024
BATCH = 8
SEQ = 8192
DEPTH = 4

CHUNK = 64
N_MIXERS = 4
EPS = 1e-6
D_FF = 2816
NEG_INF = -1e30

HGRN_HEADS = 8
HGRN_HEAD_DIM = D_MODEL // HGRN_HEADS

GLA_HEADS = 4
GLA_KEY_DIM = D_MODEL // 2
GLA_VALUE_DIM = D_MODEL
GLA_HEAD_K = GLA_KEY_DIM // GLA_HEADS
GLA_HEAD_V = GLA_VALUE_DIM // GLA_HEADS
GLA_GATE_RANK = 16
GLA_GATE_NORMALIZER = 16.0

ATTN_HEADS = 16
ATTN_HEAD_DIM = D_MODEL // ATTN_HEADS
LEFT_CHUNKS = 8
BAND = (LEFT_CHUNKS + 1) * CHUNK
REL_CLIP = 2 * CHUNK
N_REL = REL_CLIP + CHUNK

LRU_WIDTH = D_MODEL
LRU_HEADS = 4
LRU_BLOCK = LRU_WIDTH // LRU_HEADS
CONV_WIDTH = 4
LRU_C = 8.0

kernel_name = 'hybrid_chunk_causal_encoder'


def rms_norm(x, gain):
    xf = x.astype(jnp.float32)
    y = xf * lax.rsqrt(jnp.mean(xf * xf, axis=-1, keepdims=True) + EPS)
    return (y * gain.astype(jnp.float32)).astype(x.dtype)


def swiglu(h, w_gate_up, w_down):
    g, u = jnp.split(h @ w_gate_up, 2, axis=-1)
    return (jax.nn.silu(g) * u) @ w_down


def split_heads(t, n_heads):
    b, l, _ = t.shape
    return t.reshape(b, l, n_heads, -1).transpose(0, 2, 1, 3)


def merge_heads(t):
    b, h, l, d = t.shape
    return t.transpose(0, 2, 1, 3).reshape(b, l, h * d)


def chunk_gated_linear_attention(q, k, v, log_f, scale):
    b, h, l, dk = q.shape
    dv = v.shape[-1]
    n = l // CHUNK
    out_dtype = v.dtype

    def to_chunks(t):
        t = t.astype(jnp.float32)
        return jnp.moveaxis(t.reshape(b, h, n, CHUNK, t.shape[-1]), 2, 0)

    qc, kc, vc, gc = to_chunks(q * scale), to_chunks(k), to_chunks(v), to_chunks(log_f)
    causal = jnp.tril(jnp.ones((CHUNK, CHUNK), dtype=bool))

    def step(state, inp):
        q_i, k_i, v_i, g_i = inp
        cum = jnp.cumsum(g_i, axis=-2)
        rel = cum[..., :, None, :] - cum[..., None, :, :]
        decay = jnp.exp(jnp.where(causal[:, :, None], rel, -jnp.inf))
        scores = jnp.einsum('bhtk,bhsk,bhtsk->bhts', q_i, k_i, decay)
        o = (jnp.einsum('bhts,bhsv->bhtv', scores, v_i)
             + jnp.einsum('bhtk,bhkv->bhtv', q_i * jnp.exp(cum), state))
        last = cum[..., -1:, :]
        state = (jnp.exp(last[..., 0, :])[..., None] * state
                 + jnp.einsum('bhsk,bhsv->bhkv', k_i * jnp.exp(last - cum), v_i))
        return state, o

    s0 = jnp.zeros((b, h, dk, dv), jnp.float32)
    _, o = lax.scan(step, s0, (qc, kc, vc, gc))
    return jnp.moveaxis(o, 0, 2).reshape(b, h, l, dv).astype(out_dtype)


def hgrn2_mixer(h, w_in, lower_bound, norm_gain, w_out):
    q, f, i, g = jnp.split(h @ w_in, 4, axis=-1)
    q = jax.nn.silu(q)
    fgate = lower_bound + (1.0 - lower_bound) * jax.nn.sigmoid(f.astype(jnp.float32))
    k = 1.0 - fgate
    log_f = jnp.log(fgate)
    o = chunk_gated_linear_attention(split_heads(q, HGRN_HEADS), split_heads(k, HGRN_HEADS),
                                     split_heads(i, HGRN_HEADS), split_heads(log_f, HGRN_HEADS),
                                     HGRN_HEAD_DIM ** -0.5)
    o = merge_heads(rms_norm(o, norm_gain)) * jax.nn.silu(g)
    return o @ w_out


def gla_mixer(h, w_in, w_gate_down, w_gate_up, gate_bias, norm_gain, w_out):
    q, k, v, g = jnp.split(h @ w_in, [GLA_KEY_DIM, 2 * GLA_KEY_DIM, 2 * GLA_KEY_DIM + GLA_VALUE_DIM], axis=-1)
    gate_logits = ((h @ w_gate_down) @ w_gate_up + gate_bias).astype(jnp.float32)
    log_f = jax.nn.log_sigmoid(gate_logits) / GLA_GATE_NORMALIZER
    o = chunk_gated_linear_attention(split_heads(q, GLA_HEADS), split_heads(k, GLA_HEADS),
                                     split_heads(v, GLA_HEADS), split_heads(log_f, GLA_HEADS),
                                     GLA_HEAD_K ** -0.5)
    o = merge_heads(rms_norm(o, norm_gain)) * jax.nn.silu(g)
    return o @ w_out


def chunked_relbias_attention(h, w_qkv, rel_table, w_out):
    b, l, _ = h.shape
    n = l // CHUNK
    pad = BAND - CHUNK
    q, k, v = jnp.split(h @ w_qkv, 3, axis=-1)
    q = split_heads(q * ATTN_HEAD_DIM ** -0.5, ATTN_HEADS)
    k = split_heads(k, ATTN_HEADS)
    v = split_heads(v, ATTN_HEADS)
    kp = jnp.pad(k, ((0, 0), (0, 0), (pad, 0), (0, 0)))
    vp = jnp.pad(v, ((0, 0), (0, 0), (pad, 0), (0, 0)))
    dist = jnp.arange(CHUNK)[:, None] + pad - jnp.arange(BAND)[None, :]
    rel_idx = jnp.clip(dist, -(CHUNK - 1), REL_CLIP) + (CHUNK - 1)
    bias = rel_table.astype(jnp.float32)[:, rel_idx]
    qc = jnp.moveaxis(q.reshape(b, ATTN_HEADS, n, CHUNK, ATTN_HEAD_DIM), 2, 0)

    def one_chunk(args):
        c, q_c = args
        start = c * CHUNK
        k_band = lax.dynamic_slice_in_dim(kp, start, BAND, axis=2)
        v_band = lax.dynamic_slice_in_dim(vp, start, BAND, axis=2)
        scores = jnp.einsum('bhtd,bhsd->bhts', q_c, k_band).astype(jnp.float32) + bias
        key_pos = start - pad + jnp.arange(BAND)
        scores = jnp.where(key_pos >= 0, scores, NEG_INF)
        p = jax.nn.softmax(scores, axis=-1).astype(v_band.dtype)
        return jnp.einsum('bhts,bhsd->bhtd', p, v_band)

    o = lax.map(one_chunk, (jnp.arange(n), qc))
    o = jnp.moveaxis(o, 0, 2).reshape(b, ATTN_HEADS, l, ATTN_HEAD_DIM)
    return merge_heads(o) @ w_out


def causal_depthwise_conv(x, w, bias):
    y = lax.conv_general_dilated(x, w[:, None, :].astype(x.dtype), window_strides=(1,),
                                 padding=[(CONV_WIDTH - 1, 0)],
                                 dimension_numbers=('NWC', 'WIO', 'NWC'),
                                 feature_group_count=x.shape[-1])
    return y + bias


def _linear_combine(left, right):
    a1, b1 = left
    a2, b2 = right
    return a1 * a2, a2 * b1 + b2


def rg_lru(x, w_a, b_a, w_x, b_x, lam):
    b, l, w = x.shape
    xf = x.astype(jnp.float32)
    xh = xf.reshape(b, l, LRU_HEADS, LRU_BLOCK)
    r = jax.nn.sigmoid(jnp.einsum('blhi,hij->blhj', xh, w_a.astype(jnp.float32)).reshape(b, l, w) + b_a)
    i = jax.nn.sigmoid(jnp.einsum('blhi,hij->blhj', xh, w_x.astype(jnp.float32)).reshape(b, l, w) + b_x)
    log_a = -LRU_C * r * jax.nn.softplus(-lam.astype(jnp.float32))
    a = jnp.exp(log_a)
    mult = jnp.sqrt(-jnp.expm1(2.0 * log_a))
    mult = mult.at[:, 0].set(1.0)
    _, hs = lax.associative_scan(_linear_combine, (a, mult * i * xf), axis=1)
    return hs.astype(x.dtype)


def rglru_mixer(h, w_in, conv_w, conv_b, w_a, b_a, w_x, b_x, lam, w_out):
    y, xb = jnp.split(h @ w_in, 2, axis=-1)
    y = jax.nn.gelu(y, approximate=True)
    xb = causal_depthwise_conv(xb, conv_w, conv_b)
    hr = rg_lru(xb, w_a, b_a, w_x, b_x, lam)
    return (y * hr) @ w_out


def setup_inputs(seed: int = 0) -> dict:
    key = jax.random.key(seed)
    keys = iter(jax.random.split(key, 32))

    def normal(shape, scale):
        return scale * jax.random.normal(next(keys), shape, jnp.float32)

    n_a, n_b, n_c, n_d = [len(range(m, DEPTH, N_MIXERS)) for m in range(N_MIXERS)]
    d = D_MODEL
    a0 = jax.random.uniform(next(keys), (n_d, LRU_WIDTH), jnp.float32, minval=0.9, maxval=0.999)
    return {
        'x': normal((BATCH, SEQ, d), 1.0),
        'ffn_w_gate_up': normal((DEPTH, 2, d, 2 * D_FF), d ** -0.5),
        'ffn_w_down': normal((DEPTH, 2, D_FF, d), D_FF ** -0.5),
        'norm_gains': 1.0 + normal((DEPTH, 3, d), 0.02),
        'final_norm_gain': 1.0 + normal((d,), 0.02),
        'hgrn_w_in': normal((n_a, d, 4 * d), d ** -0.5),
        'hgrn_lower_bound_logits': normal((DEPTH + 1, d), 0.5),
        'hgrn_norm_gain': 1.0 + normal((n_a, HGRN_HEAD_DIM), 0.02),
        'hgrn_w_out': normal((n_a, d, d), d ** -0.5),
        'gla_w_in': normal((n_b, d, 2 * GLA_KEY_DIM + 2 * GLA_VALUE_DIM), d ** -0.5),
        'gla_w_gate_down': normal((n_b, d, GLA_GATE_RANK), d ** -0.5),
        'gla_w_gate_up': normal((n_b, GLA_GATE_RANK, GLA_KEY_DIM), GLA_GATE_RANK ** -0.5),
        'gla_gate_bias': normal((n_b, GLA_KEY_DIM), 0.1),
        'gla_norm_gain': 1.0 + normal((n_b, GLA_HEAD_V), 0.02),
        'gla_w_out': normal((n_b, GLA_VALUE_DIM, d), GLA_VALUE_DIM ** -0.5),
        'attn_w_qkv': normal((n_c, d, 3 * d), d ** -0.5),
        'attn_rel_bias': normal((n_c, ATTN_HEADS, N_REL), 0.1),
        'attn_w_out': normal((n_c, d, d), d ** -0.5),
        'lru_w_in': normal((n_d, d, 2 * LRU_WIDTH), d ** -0.5),
        'lru_conv_w': normal((n_d, CONV_WIDTH, LRU_WIDTH), CONV_WIDTH ** -0.5),
        'lru_conv_b': normal((n_d, LRU_WIDTH), 0.02),
        'lru_w_a': normal((n_d, LRU_HEADS, LRU_BLOCK, LRU_BLOCK), LRU_BLOCK ** -0.5),
        'lru_b_a': normal((n_d, LRU_WIDTH), 0.02),
        'lru_w_x': normal((n_d, LRU_HEADS, LRU_BLOCK, LRU_BLOCK), LRU_BLOCK ** -0.5),
        'lru_b_x': normal((n_d, LRU_WIDTH), 0.02),
        'lru_lambda': jnp.log(a0) - jnp.log1p(-a0),
        'lru_w_out': normal((n_d, LRU_WIDTH, d), LRU_WIDTH ** -0.5),
    }


def reference(x, ffn_w_gate_up, ffn_w_down, norm_gains, final_norm_gain,
              hgrn_w_in, hgrn_lower_bound_logits, hgrn_norm_gain, hgrn_w_out,
              gla_w_in, gla_w_gate_down, gla_w_gate_up, gla_gate_bias, gla_norm_gain, gla_w_out,
              attn_w_qkv, attn_rel_bias, attn_w_out,
              lru_w_in, lru_conv_w, lru_conv_b, lru_w_a, lru_b_a, lru_w_x, lru_b_x, lru_lambda, lru_w_out):
    lower_bounds = jnp.cumsum(jax.nn.softmax(hgrn_lower_bound_logits.astype(jnp.float32), axis=0), axis=0)
    for i in range(DEPTH):
        m, j = i % N_MIXERS, i // N_MIXERS
        x = x + 0.5 * swiglu(rms_norm(x, norm_gains[i, 0]), ffn_w_gate_up[i, 0], ffn_w_down[i, 0])
        h = rms_norm(x, norm_gains[i, 1])
        if m == 0:
            y = hgrn2_mixer(h, hgrn_w_in[j], lower_bounds[i], hgrn_norm_gain[j], hgrn_w_out[j])
        elif m == 1:
            y = gla_mixer(h, gla_w_in[j], gla_w_gate_down[j], gla_w_gate_up[j], gla_gate_bias[j],
                          gla_norm_gain[j], gla_w_out[j])
        elif m == 2:
            y = chunked_relbias_attention(h, attn_w_qkv[j], attn_rel_bias[j], attn_w_out[j])
        else:
            y = rglru_mixer(h, lru_w_in[j], lru_conv_w[j], lru_conv_b[j], lru_w_a[j], lru_b_a[j],
                            lru_w_x[j], lru_b_x[j], lru_lambda[j], lru_w_out[j])
        x = x + y
        x = x + 0.5 * swiglu(rms_norm(x, norm_gains[i, 2]), ffn_w_gate_up[i, 1], ffn_w_down[i, 1])
    return rms_norm(x, final_norm_gain)
```

```cpp
#include <hip/hip_runtime.h>
#include <hip/hip_cooperative_groups.h>
#include <cstdio>
#include <cstdint>
namespace cg = cooperative_groups;

#ifndef ONE_LAUNCH
#define ONE_LAUNCH 1
#endif

#define LAS __attribute__((address_space(3)))
#define GAS __attribute__((address_space(1)))
typedef unsigned short bf16_t;
typedef short bf16x8 __attribute__((ext_vector_type(8)));
typedef float f32x4 __attribute__((ext_vector_type(4)));
typedef unsigned u32x4 __attribute__((ext_vector_type(4)));
typedef unsigned u32x2 __attribute__((ext_vector_type(2)));

constexpr int M = 65536, DM = 1024, FF = 2816, SEQ = 8192, NB = 8, NCHUNK = 128;
constexpr float EPS = 1e-6f;

constexpr size_t MiB = (size_t)1 << 20;
constexpr size_t WS_W = 2 * MiB;
constexpr size_t FFN_STRIDE = 17301504;
constexpr size_t WD_OFF = 11 * MiB;
constexpr size_t WS_HG_IN = 134 * MiB, WS_HG_OUT = 142 * MiB, WS_GL_IN = 144 * MiB, WS_GL_OUT = 151 * MiB, WS_AT_IN = 153 * MiB, WS_AT_OUT = 159 * MiB,
                 WS_LR_IN = 161 * MiB, WS_LR_GATE = 165 * MiB, WS_LR_OUT = 166 * MiB;
constexpr size_t WS_H = 168 * MiB;
constexpr size_t WS_R1 = 296 * MiB;
constexpr size_t WS_R2 = 808 * MiB;
constexpr size_t WS_DL = 872 * MiB;
constexpr size_t WS_XR = 876 * MiB;
constexpr size_t WS_SSP = 1004 * MiB;
constexpr size_t WS_RSTD = 1008 * MiB;
constexpr size_t WS_END = 1009 * MiB;
constexpr int LDS_STAT = 131072;
constexpr int LDS_BAR = 131072 + 2048;
constexpr int LDS_BYTES = 131072 + 2048 + 64;

__device__ __forceinline__ float bflo(unsigned u) { return __uint_as_float(u << 16); }
__device__ __forceinline__ float bfhi(unsigned u) { return __uint_as_float(u & 0xffff0000u); }
typedef float f32x2_t __attribute__((ext_vector_type(2)));
typedef __bf16 bf16x2_t __attribute__((ext_vector_type(2)));
__device__ __forceinline__ unsigned pkbf(float lo, float hi) { const f32x2_t v = {lo, hi}; const bf16x2_t b = __builtin_convertvector(v, bf16x2_t); return __builtin_bit_cast(unsigned, b); }
__device__ __forceinline__ float frcp(float x) { return __builtin_amdgcn_rcpf(x); }
__device__ __forceinline__ float sigm(float x) { return frcp(1.0f + __expf(-x)); }
__device__ __forceinline__ float silu(float x) { return x * sigm(x); }
__device__ __forceinline__ float shx(float v, int off, int lane) { return __int_as_float(__builtin_amdgcn_ds_bpermute((lane ^ off) << 2, __float_as_int(v))); }
__device__ __forceinline__ float wave_sum(float v, int lane) {
#pragma unroll
    for (int o = 1; o < 64; o <<= 1) v += shx(v, o, lane);
    return v;
}
__device__ __forceinline__ float xmax16(float v) { const auto r = __builtin_amdgcn_permlane16_swap(__float_as_uint(v), __float_as_uint(v), false, false); return fmaxf(__uint_as_float(r[0]), __uint_as_float(r[1])); }
__device__ __forceinline__ float xmax32(float v) { const auto r = __builtin_amdgcn_permlane32_swap(__float_as_uint(v), __float_as_uint(v), false, false); return fmaxf(__uint_as_float(r[0]), __uint_as_float(r[1])); }
__device__ __forceinline__ float xsum16(float v) { const auto r = __builtin_amdgcn_permlane16_swap(__float_as_uint(v), __float_as_uint(v), false, false); return __uint_as_float(r[0]) + __uint_as_float(r[1]); }
__device__ __forceinline__ float xsum32(float v) { const auto r = __builtin_amdgcn_permlane32_swap(__float_as_uint(v), __float_as_uint(v), false, false); return __uint_as_float(r[0]) + __uint_as_float(r[1]); }
#define MFMA16(a, b, c) __builtin_amdgcn_mfma_f32_16x16x32_bf16((a), (b), (c), 0, 0, 0)

namespace pg8 {
constexpr int BM = 256, BK = 64, HALF = 128, HTB = HALF * BK * 2, STAGE_BYTES = 8 * HTB, NXCD = 8, WGM = 8;
__host__ __device__ __forceinline__ int lds_byte(int r, int c) { const int st = (r >> 4) * 2 + (c >> 5), rr = r & 15, cc = c & 31, ob = rr * 64 + cc * 2; return st * 1024 + (ob ^ (((ob >> 9) & 1) << 5)); }
__host__ __device__ __forceinline__ void stage_rc(int b, int& R, int& C) { const int st = b / 1024, sb = b % 1024, swz = sb ^ (((sb >> 9) & 1) << 5); R = (st >> 1) * 16 + swz / 64; C = (st & 1) * 32 + (swz % 64) / 2; }
__host__ __device__ __forceinline__ int perm32(int rho) { const int n = rho >> 4, i = rho & 15; return 8 * (i >> 2) + 4 * n + (i & 3); }

struct Unit { int pm, pn; };
struct Gemm { const bf16_t* A; const bf16_t* Bt; int M, N, K, lda, acol_div; };

struct StaticOrder {
    int nM, nN, nwg, G, c;
    __device__ void init(int M_, int N_, int G_, int c_) { nM = M_ / BM; nN = N_ / BM; nwg = nM * nN; G = G_; c = c_; }
    __device__ bool next(int i, Unit& u) const {
        const long L = (long)i * G + c; if (L >= nwg) return false;
        int wgid = (int)L; { const int q = nwg / NXCD, r = nwg % NXCD, xcd = wgid % NXCD, off = wgid / NXCD; wgid = (xcd < r ? xcd * (q + 1) : r * (q + 1) + (xcd - r) * q) + off; }
        const int nig = WGM * nN, gid = wgid / nig, fm = gid * WGM, gsz = (nM - fm) < WGM ? (nM - fm) : WGM;
        u.pm = fm + ((wgid % nig) % gsz); u.pn = (wgid % nig) / gsz; return true;
    }
};


struct EpiStore {
    static constexpr bool HAS_RS = true;
    bf16_t* O; int ldc; const float* rstd;
    __device__ __forceinline__ void operator()(const f32x4 (&acc)[2][2][4][2], const Unit& u, int wr, int wc, int fr, int fq, LAS unsigned char* lds, int par) const {
        asm volatile("" : "+v"(fr), "+v"(fq));
        const int row0 = u.pm * BM + wr * 64 + fr, col0 = u.pn * BM + wc * 32 + 8 * fq;
#pragma unroll
        for (int ai = 0; ai < 2; ++ai)
#pragma unroll
            for (int m = 0; m < 4; ++m) { GAS bf16_t* rowp = (GAS bf16_t*)O + (size_t)(row0 + ai * HALF + m * 16) * ldc + col0;
                const float rs = rstd ? ((const LAS float*)(lds + LDS_STAT))[par * 256 + wr * 64 + fr + ai * HALF + m * 16] : 1.0f;
#pragma unroll
                for (int bj = 0; bj < 2; ++bj) { const f32x4 v0 = acc[ai][bj][m][0] * rs, v1 = acc[ai][bj][m][1] * rs;
                    u32x4 w; w.x = pkbf(v0[0], v0[1]); w.y = pkbf(v0[2], v0[3]); w.z = pkbf(v1[0], v1[1]); w.w = pkbf(v1[2], v1[3]);
                    *(GAS u32x4*)(rowp + bj * HALF) = w; } }
    }
};
struct EpiSwiGLU {
    static constexpr bool HAS_RS = true;
    bf16_t* O; const float* rstd;
    __device__ __forceinline__ void operator()(const f32x4 (&acc)[2][2][4][2], const Unit& u, int wr, int wc, int fr, int fq, LAS unsigned char* lds, int par) const {
        asm volatile("" : "+v"(fr), "+v"(fq));
        const int row0 = u.pm * BM + wr * 64 + fr, col0 = u.pn * HALF + wc * 32 + 8 * fq;
#pragma unroll
        for (int ai = 0; ai < 2; ++ai)
#pragma unroll
            for (int m = 0; m < 4; ++m) { GAS bf16_t* rowp = (GAS bf16_t*)O + (size_t)(row0 + ai * HALF + m * 16) * FF + col0;
                const float rs = ((const LAS float*)(lds + LDS_STAT))[par * 256 + wr * 64 + fr + ai * HALF + m * 16];
                unsigned r[4];
#pragma unroll
                for (int n = 0; n < 2; ++n)
#pragma unroll
                    for (int j = 0; j < 4; j += 2) {
                        const f32x2_t g2 = (f32x2_t){acc[ai][0][m][n][j], acc[ai][0][m][n][j + 1]} * rs, u2 = (f32x2_t){acc[ai][1][m][n][j], acc[ai][1][m][n][j + 1]} * rs;
                        const f32x2_t t = g2 * -1.4426950408889634f; f32x2_t e; e.x = __builtin_amdgcn_exp2f(t.x); e.y = __builtin_amdgcn_exp2f(t.y);
                        const f32x2_t d = e + 1.0f; f32x2_t q; q.x = __builtin_amdgcn_rcpf(d.x); q.y = __builtin_amdgcn_rcpf(d.y);
                        const f32x2_t o = (g2 * u2) * q; r[n * 2 + (j >> 1)] = pkbf(o.x, o.y); }
                u32x4 w; w.x = r[0]; w.y = r[1]; w.z = r[2]; w.w = r[3];
                *(GAS u32x4*)rowp = w; }
    }
};
struct EpiResid {
    static constexpr bool HAS_RS = false;
    bf16_t* X; float scale; float* ssp; const float* rstd;
    __device__ __forceinline__ void operator()(const f32x4 (&acc)[2][2][4][2], const Unit& u, int wr, int wc, int fr, int fq, LAS unsigned char* lds, int par) const {
        asm volatile("" : "+v"(fr), "+v"(fq));
        const int row0 = u.pm * BM + wr * 64 + fr, col0 = u.pn * BM + wc * 32 + 8 * fq, lane = fq * 16 + fr;
        GAS float* sslot = (GAS float*)ssp + (size_t)(u.pn * 4 + wc) * M;
#pragma unroll
        for (int ai = 0; ai < 2; ++ai) {
            GAS bf16_t* base = (GAS bf16_t*)X + (size_t)(row0 + ai * HALF) * DM + col0;
            u32x4 xv[4][2];
#pragma unroll
            for (int m = 0; m < 4; ++m)
#pragma unroll
                for (int bj = 0; bj < 2; ++bj) xv[m][bj] = *(const GAS u32x4*)(base + (size_t)m * 16 * DM + bj * HALF);
            asm volatile("" ::: "memory");
#pragma unroll
            for (int m = 0; m < 4; ++m) { float sq = 0.f;
#pragma unroll
                for (int bj = 0; bj < 2; ++bj) { const u32x4 x = xv[m][bj]; const f32x4 a0 = acc[ai][bj][m][0] * scale, a1 = acc[ai][bj][m][1] * scale;
                    u32x4 w; w.x = pkbf(bflo(x.x) + a0[0], bfhi(x.x) + a0[1]); w.y = pkbf(bflo(x.y) + a0[2], bfhi(x.y) + a0[3]);
                    w.z = pkbf(bflo(x.z) + a1[0], bfhi(x.z) + a1[1]); w.w = pkbf(bflo(x.w) + a1[2], bfhi(x.w) + a1[3]);
                    *(GAS u32x4*)(base + (size_t)m * 16 * DM + bj * HALF) = w;
                    const float e0 = bflo(w.x), e1 = bfhi(w.x), e2 = bflo(w.y), e3 = bfhi(w.y), e4 = bflo(w.z), e5 = bfhi(w.z), e6 = bflo(w.w), e7 = bfhi(w.w);
                    sq += ((e0 * e0 + e1 * e1) + (e2 * e2 + e3 * e3)) + ((e4 * e4 + e5 * e5) + (e6 * e6 + e7 * e7)); }
                sq = xsum32(xsum16(sq));
                if (fq == 0) sslot[row0 + ai * HALF + m * 16] = sq; }
            asm volatile("" ::: "memory");
        }
    }
};
template <class Epi>
__device__ __forceinline__ void gemm_phase(const int tid, LAS unsigned char* lds, const Gemm g, const StaticOrder& S, const Epi& E) {
    const int wid = __builtin_amdgcn_readfirstlane(tid >> 6), lane = tid & 63, wr = wid >> 2, wc = wid & 3, fr = lane & 15, fq = lane >> 4;
    const int K = g.K, nt = K / BK, lda = g.lda;
    unsigned voffA[2], voffB[2];
#pragma unroll
    for (int i = 0; i < 2; ++i) { int R, C; stage_rc(tid * 16 + i * 8192, R, C); const int Rb = (R & ~31) + perm32(R & 31);
        voffA[i] = (unsigned)(R * lda + C) * 2u; voffB[i] = (unsigned)(Rb * K + C) * 2u; }
    const size_t kstep = (size_t)(BK * 2);
    const size_t hstepA = (size_t)HALF * lda * 2, hstepB = (size_t)HALF * K * 2;
    const size_t tstepA = 2 * hstepA, tstepB = 2 * hstepB;
    const unsigned ldsw = (unsigned)wid * 1024u;
    const int aoff = lds_byte(wr * 64 + fr, fq * 8), boff = lds_byte(wc * 32 + fr, fq * 8);
#define PG8_SA(b, h) (((b) * 2 + (h)) * HTB)
#define PG8_SB(b, h) ((4 + (b) * 2 + (h)) * HTB)
#define PG8_STAGE(bufoff, gbase, voff) do { _Pragma("unroll") for (int _i = 0; _i < 2; ++_i) \
        __builtin_amdgcn_global_load_lds((const unsigned*)((const char*)(gbase) + (voff)[_i]), (LAS unsigned*)(lds + (bufoff) + ldsw + _i * 8192), 16, 0, 0); } while (0)
#define PG8_LDA(dst, b, h) do { _Pragma("unroll") for (int m = 0; m < 4; ++m) _Pragma("unroll") for (int k = 0; k < 2; ++k) dst[m][k] = *(const LAS bf16x8*)(lds + PG8_SA(b, h) + aoff + m * 2048 + k * 1024); } while (0)
#define PG8_LDB(dst, b, h) do { _Pragma("unroll") for (int n = 0; n < 2; ++n) _Pragma("unroll") for (int k = 0; k < 2; ++k) dst[n][k] = *(const LAS bf16x8*)(lds + PG8_SB(b, h) + boff + n * 2048 + k * 1024); } while (0)
#define PG8_MMA(ai, bj, At, Bt) do { __builtin_amdgcn_s_setprio(1); _Pragma("unroll") for (int m = 0; m < 4; ++m) _Pragma("unroll") for (int n = 0; n < 2; ++n) _Pragma("unroll") for (int k = 0; k < 2; ++k) \
        acc[ai][bj][m][n] = __builtin_amdgcn_mfma_f32_16x16x32_bf16(Bt[n][k], At[m][k], acc[ai][bj][m][n], 0, 0, 0); __builtin_amdgcn_s_setprio(0); } while (0)
#define PG8_WAIT_V(n) asm volatile("s_waitcnt vmcnt(" #n ")" ::: "memory")
#define PG8_WAIT_L(n) asm volatile("s_waitcnt lgkmcnt(" #n ")" ::: "memory")
#define PG8_BAR __builtin_amdgcn_s_barrier()
#define PG8_SCHED __builtin_amdgcn_sched_barrier(0)
#define PG8_ACOL(pn) ((size_t)(g.acol_div ? ((pn) / g.acol_div) * 512 : 0))
    Unit cur, nxt; int ui = 0;
    if (!S.next(0, cur)) return;
    f32x4 acc[2][2][4][2];
#pragma unroll
    for (int a = 0; a < 2; ++a)
#pragma unroll
        for (int b = 0; b < 2; ++b)
#pragma unroll
            for (int m = 0; m < 4; ++m)
#pragma unroll
                for (int n = 0; n < 2; ++n) acc[a][b][m][n] = (f32x4){0.f, 0.f, 0.f, 0.f};
    bf16x8 At[4][2], B0[2][2], B1[2][2];
    const char* cA = (const char*)g.A + (size_t)cur.pm * tstepA + PG8_ACOL(cur.pn); const char* cB = (const char*)g.Bt + (size_t)cur.pn * tstepB;
#define PG8_RSTD(pm, par) do { if (wid == 0) __builtin_amdgcn_global_load_lds((const unsigned*)((const char*)E.rstd + (size_t)(pm) * 1024 + (lane << 4)), (LAS unsigned*)(lds + LDS_STAT + (par) * 1024), 16, 0, 0); } while (0)
    if constexpr (Epi::HAS_RS) { if (E.rstd) PG8_RSTD(cur.pm, 0); }
    PG8_STAGE(PG8_SB(0, 0), cB, voffB); PG8_STAGE(PG8_SB(0, 1), cB + hstepB, voffB); PG8_STAGE(PG8_SA(0, 0), cA, voffA); PG8_STAGE(PG8_SA(0, 1), cA + hstepA, voffA);
    if (wr == 1) PG8_BAR;
    PG8_WAIT_V(2); PG8_BAR;
    PG8_STAGE(PG8_SB(1, 0), cB + kstep, voffB); PG8_STAGE(PG8_SA(1, 0), cA + kstep, voffA); PG8_STAGE(PG8_SB(1, 1), cB + hstepB + kstep, voffB);
    PG8_WAIT_V(6); PG8_BAR;
    for (;;) {
        const bool has_next = S.next(ui + 1, nxt);
        const char* nA = has_next ? (const char*)g.A + (size_t)nxt.pm * tstepA + PG8_ACOL(nxt.pn) : cA; const char* nB = has_next ? (const char*)g.Bt + (size_t)nxt.pn * tstepB : cB;
        for (int t = 0; t < nt; t += 2) {
            const bool last = (t == nt - 2);
            const char* a1 = cA + (size_t)(t + 1) * kstep;
            const char* a2 = last ? nA : cA + (size_t)(t + 2) * kstep; const char* b2 = last ? nB : cB + (size_t)(t + 2) * kstep;
            const char* a3 = a2 + kstep; const char* b3 = b2 + kstep;
            PG8_LDB(B0, 0, 0); PG8_LDB(B1, 0, 1); PG8_SCHED; PG8_LDA(At, 0, 0); PG8_STAGE(PG8_SA(1, 1), a1 + hstepA, voffA);
            PG8_WAIT_V(8); PG8_WAIT_L(0); PG8_BAR; PG8_MMA(0, 0, At, B0); PG8_MMA(0, 1, At, B1); PG8_BAR; PG8_SCHED;
            PG8_LDA(At, 0, 1); PG8_STAGE(PG8_SB(0, 0), b2, voffB); PG8_STAGE(PG8_SB(0, 1), b2 + hstepB, voffB); PG8_STAGE(PG8_SA(0, 0), a2, voffA);
            PG8_WAIT_V(8); PG8_WAIT_L(0); PG8_BAR; PG8_MMA(1, 0, At, B0); PG8_MMA(1, 1, At, B1); PG8_BAR; PG8_SCHED;
            PG8_LDB(B0, 1, 0); PG8_LDB(B1, 1, 1); PG8_SCHED; PG8_LDA(At, 1, 0); PG8_STAGE(PG8_SA(0, 1), a2 + hstepA, voffA);
            PG8_WAIT_V(8); PG8_WAIT_L(0); PG8_BAR; PG8_MMA(0, 0, At, B0); PG8_MMA(0, 1, At, B1); PG8_BAR; PG8_SCHED;
            PG8_LDA(At, 1, 1); PG8_STAGE(PG8_SB(1, 0), b3, voffB); PG8_STAGE(PG8_SB(1, 1), b3 + hstepB, voffB); PG8_STAGE(PG8_SA(1, 0), a3, voffA);
            PG8_WAIT_V(8); PG8_WAIT_L(0); PG8_BAR; PG8_MMA(1, 0, At, B0); PG8_MMA(1, 1, At, B1); PG8_BAR; PG8_SCHED;
        }
        if (wr == 0) PG8_BAR;
        E(acc, cur, wr, wc, fr, fq, lds, ui & 1);
        if (!has_next) break;
#pragma unroll
        for (int a = 0; a < 2; ++a)
#pragma unroll
            for (int b = 0; b < 2; ++b)
#pragma unroll
                for (int m = 0; m < 4; ++m)
#pragma unroll
                    for (int n = 0; n < 2; ++n) acc[a][b][m][n] = (f32x4){0.f, 0.f, 0.f, 0.f};
        cur = nxt; cA = nA; cB = nB; ++ui;
        if (wr == 1) PG8_BAR;
        if constexpr (Epi::HAS_RS) { if (E.rstd) PG8_RSTD(cur.pm, ui & 1); }
    }
    PG8_WAIT_V(0);
    PG8_BAR;
#undef PG8_SA
#undef PG8_SB
#undef PG8_STAGE
#undef PG8_LDA
#undef PG8_LDB
#undef PG8_MMA
#undef PG8_WAIT_V
#undef PG8_WAIT_L
#undef PG8_BAR
#undef PG8_SCHED
#undef PG8_ACOL
#undef PG8_RSTD
}
}

struct WJob { const float* src; const float* gain; int K, N, kind, aux; bf16_t* dst; };
struct Params { const float* in[27]; float* out; unsigned char* ws; int ph_lo, ph_hi; };

__device__ __forceinline__ const float* inp(const Params& p, int k);
__device__ __forceinline__ WJob wjob(const Params& p, unsigned char* ws, int j) {
    WJob w; w.kind = 0; w.aux = 0; w.gain = nullptr;
    const float* ng = inp(p, 3);
    if (j < 16) { const int f = j >> 1;
        if ((j & 1) == 0) { w.src = inp(p, 1) + (size_t)f * DM * 2 * FF; w.K = DM; w.N = 2 * FF; w.kind = 1; w.gain = ng + (size_t)((f >> 1) * 3 + ((f & 1) ? 2 : 0)) * DM; w.dst = (bf16_t*)(ws + WS_W + f * FFN_STRIDE); }
        else { w.src = inp(p, 2) + (size_t)f * FF * DM; w.K = FF; w.N = DM; w.dst = (bf16_t*)(ws + WS_W + f * FFN_STRIDE + WD_OFF); }
        return w; }
    switch (j) {
        case 16: w.src = inp(p, 5); w.gain = ng + (size_t)(0 * 3 + 1) * DM; w.K = DM; w.N = 4096; w.dst = (bf16_t*)(ws + WS_HG_IN); break;
        case 17: w.src = inp(p, 8); w.K = DM; w.N = DM; w.dst = (bf16_t*)(ws + WS_HG_OUT); break;
        case 18: w.src = inp(p, 9); w.gain = ng + (size_t)(1 * 3 + 1) * DM; w.K = DM; w.N = 3072; w.dst = (bf16_t*)(ws + WS_GL_IN); break;
        case 19: w.src = inp(p, 10); w.gain = ng + (size_t)(1 * 3 + 1) * DM; w.K = DM; w.N = 512; w.kind = 2; w.dst = (bf16_t*)(ws + WS_GL_IN) + (size_t)3072 * DM; break;
        case 20: w.src = inp(p, 14); w.K = DM; w.N = DM; w.dst = (bf16_t*)(ws + WS_GL_OUT); break;
        case 21: w.src = inp(p, 15); w.gain = ng + (size_t)(2 * 3 + 1) * DM; w.K = DM; w.N = 3072; w.dst = (bf16_t*)(ws + WS_AT_IN); break;
        case 22: w.src = inp(p, 17); w.K = DM; w.N = DM; w.dst = (bf16_t*)(ws + WS_AT_OUT); break;
        case 23: w.src = inp(p, 18); w.gain = ng + (size_t)(3 * 3 + 1) * DM; w.K = DM; w.N = 2048; w.dst = (bf16_t*)(ws + WS_LR_IN); break;
        case 32: w.src = inp(p, 26); w.K = DM; w.N = DM; w.dst = (bf16_t*)(ws + WS_LR_OUT); break;
        default: { const int q = j - 24, gsel = q >> 2, head = q & 3; w.src = inp(p, gsel ? 23 : 21) + (size_t)head * 65536; w.K = 256; w.N = 256; w.kind = 3; w.aux = q; w.dst = (bf16_t*)(ws + WS_LR_GATE); } break;
    }
    return w;
}
constexpr int NWJOBS = 33;

__device__ __forceinline__ void weights_phase(const int tid, const int bid, const int G, const Params& p, unsigned char* ws, unsigned char* lds) {
    const int lane = tid & 63, wid = __builtin_amdgcn_readfirstlane(tid >> 6);
    float* scr = (float*)(lds + wid * 8448);
    const int gw = bid * 8 + wid, NGW = G * 8;
    int base = 0;
    for (int j = 0; j < NWJOBS; ++j) {
        const WJob w = wjob(p, ws, j);
        const int nblk = w.N / 32, nitems = (w.K / 64) * nblk;
        int first = (gw - base % NGW + NGW) % NGW;
        for (int it = first; it < nitems; it += NGW) {
            const int kb = it / nblk, nb = it % nblk, k0 = 64 * kb, n0 = 32 * nb;
            if (w.kind == 2) {
                const float* wd = w.src; const float* wu = inp(p, 11);
#pragma unroll 4
                for (int i = 0; i < 32; ++i) { const int kk = 2 * i + (lane >> 5); float s = 0.f;
#pragma unroll
                    for (int r = 0; r < 16; ++r) s += wd[(size_t)(k0 + kk) * 16 + r] * wu[r * 512 + n0 + (lane & 31)];
                    scr[kk * 33 + (lane & 31)] = s; }
            } else {
#pragma unroll 8
                for (int i = 0; i < 32; ++i) { const int kk = 2 * i + (lane >> 5); scr[kk * 33 + (lane & 31)] = ((const GAS float*)w.src)[(size_t)(k0 + kk) * w.N + n0 + (lane & 31)]; }
            }
            int drow0 = n0;
            if (w.kind == 1) { const int jj = n0 < FF ? n0 : n0 - FF; drow0 = 256 * (jj >> 7) + (jj & 127) + (n0 < FF ? 0 : 128); }
            else if (w.kind == 3) { const int gsel = w.aux >> 2, head = w.aux & 3, c = 256 * head + n0; drow0 = 256 * (c >> 7) + 128 * gsel + (c & 127); }
            __builtin_amdgcn_wave_barrier();
            asm volatile("s_waitcnt lgkmcnt(0)" ::: "memory");
            const int c = lane & 7;
            f32x4 g0 = (f32x4){1.f, 1.f, 1.f, 1.f}, g1 = g0;
            if (w.gain) { g0 = *(const f32x4*)(w.gain + k0 + 8 * c); g1 = *(const f32x4*)(w.gain + k0 + 8 * c + 4); }
#pragma unroll
            for (int q = 0; q < 4; ++q) { const int n = (lane >> 3) + 8 * q; const float* s = scr + (8 * c) * 33 + n;
                u32x4 o; o.x = pkbf(s[0 * 33] * g0[0], s[1 * 33] * g0[1]); o.y = pkbf(s[2 * 33] * g0[2], s[3 * 33] * g0[3]); o.z = pkbf(s[4 * 33] * g1[0], s[5 * 33] * g1[1]); o.w = pkbf(s[6 * 33] * g1[2], s[7 * 33] * g1[3]);
                *(GAS u32x4*)((GAS bf16_t*)w.dst + (size_t)(drow0 + n) * w.K + k0 + 8 * c) = o; }
            asm volatile("s_waitcnt lgkmcnt(0)" ::: "memory");
            __builtin_amdgcn_wave_barrier();
        }
        base += nitems;
    }
}

__device__ __forceinline__ void first_phase(const int tid, const int bid, const int G, const float* src, bf16_t* xr, float* rstd) {
    const int lane = tid & 63, wid = __builtin_amdgcn_readfirstlane(tid >> 6);
    const int gw = bid * 8 + wid, NGW = G * 8;
    for (int row = gw; row < M; row += NGW) {
        const GAS f32x4* xp = (const GAS f32x4*)(src + (size_t)row * DM) + lane;
        f32x4 v[4]; float s = 0.f;
#pragma unroll
        for (int j = 0; j < 4; ++j) { v[j] = xp[64 * j]; s += (v[j].x * v[j].x + v[j].y * v[j].y) + (v[j].z * v[j].z + v[j].w * v[j].w); }
        s = wave_sum(s, lane);
        if (lane == 0) ((GAS float*)rstd)[row] = rsqrtf(s * (1.0f / DM) + EPS);
#pragma unroll
        for (int j = 0; j < 4; ++j) { u32x2 w; w.x = pkbf(v[j].x, v[j].y); w.y = pkbf(v[j].z, v[j].w); ((GAS u32x2*)(xr + (size_t)row * DM))[lane + 64 * j] = w; }
    }
}
__device__ __forceinline__ void rstd_phase(const int tid, const int bid, const int G, const float* ssp, float* rstd) {
    for (int row = bid * 512 + tid; row < M; row += G * 512) { float s0 = 0.f, s1 = 0.f;
#pragma unroll
        for (int k = 0; k < 16; k += 2) { s0 += ((const GAS float*)ssp)[(size_t)k * M + row]; s1 += ((const GAS float*)ssp)[(size_t)(k + 1) * M + row]; }
        ((GAS float*)rstd)[row] = rsqrtf((s0 + s1) * (1.0f / DM) + EPS); }
}
__device__ __forceinline__ void final_phase(const int tid, const int bid, const int G, const bf16_t* xr, const float* ssp, float* fdst, const float* gain) {
    const int lane = tid & 63, wid = __builtin_amdgcn_readfirstlane(tid >> 6);
    const int gw = bid * 8 + wid, NGW = G * 8;
    f32x4 gv[2][2];
#pragma unroll
    for (int j = 0; j < 2; ++j) { gv[j][0] = *(const f32x4*)(gain + 8 * lane + 512 * j); gv[j][1] = *(const f32x4*)(gain + 8 * lane + 512 * j + 4); }
    for (int row = gw; row < M; row += NGW) {
        const GAS bf16_t* xp = (const GAS bf16_t*)xr + (size_t)row * DM + 8 * lane;
        float sp = lane < 16 ? ((const GAS float*)ssp)[(size_t)lane * M + row] : 0.f;
        sp += shx(sp, 1, lane); sp += shx(sp, 2, lane); sp += shx(sp, 4, lane); sp += shx(sp, 8, lane);
        const float r = rsqrtf(__int_as_float(__builtin_amdgcn_readfirstlane(__float_as_int(sp))) * (1.0f / DM) + EPS);
#pragma unroll
        for (int j = 0; j < 2; ++j) { const u32x4 q = *(const GAS u32x4*)(xp + 512 * j);
            const float v[8] = {bflo(q.x), bfhi(q.x), bflo(q.y), bfhi(q.y), bflo(q.z), bfhi(q.z), bflo(q.w), bfhi(q.w)};
            GAS float* op = (GAS float*)fdst + (size_t)row * DM + 8 * lane + 512 * j;
            *(GAS f32x4*)op = (f32x4){v[0] * r * gv[j][0][0], v[1] * r * gv[j][0][1], v[2] * r * gv[j][0][2], v[3] * r * gv[j][0][3]};
            *(GAS f32x4*)(op + 4) = (f32x4){v[4] * r * gv[j][1][0], v[5] * r * gv[j][1][1], v[6] * r * gv[j][1][2], v[7] * r * gv[j][1][3]}; }
    }
}

template <int MODE>
__device__ __forceinline__ void la_prep(const int tid, const int bid, const int G, unsigned char* lds, bf16_t* P, const float* lbl, int layer, const float* gbias, bf16_t* Aout, float* dlast) {
    constexpr int H = MODE == 0 ? 8 : 4, ldp = MODE == 0 ? 4096 : 3584;
    const int lane = tid & 63, wid = __builtin_amdgcn_readfirstlane(tid >> 6), cp = lane, seg = wid, l15 = lane & 15, kq = lane >> 4;
    LAS bf16_t* sQ = (LAS bf16_t*)(LAS unsigned char*)lds; LAS bf16_t* sK = sQ + 64 * 136; LAS float* sTot = (LAS float*)(sK + 64 * 136);
    GAS bf16_t* Pg = (GAS bf16_t*)P; GAS bf16_t* Ag = (GAS bf16_t*)Aout; GAS float* Dg = (GAS float*)dlast; const GAS float* lblg = (const GAS float*)lbl; const GAS float* gbg = (const GAS float*)gbias;
    const float scale = 0.08838834764831845f;
    constexpr int nunits = NB * H * NCHUNK;
    unsigned nq[8], nk[8], nl[8];
#define LAP_FETCH(uu) do { const int c_ = (uu) & 127, h_ = ((uu) >> 7) % H, b_ = ((uu) >> 7) / H; const GAS bf16_t* rp_ = Pg + ((size_t)b_ * SEQ + (size_t)c_ * 64 + seg * 8) * ldp + 2 * cp + h_ * 128; \
        _Pragma("unroll") for (int i_ = 0; i_ < 8; ++i_) { nq[i_] = *(const GAS unsigned*)(rp_ + (size_t)i_ * ldp); nk[i_] = *(const GAS unsigned*)(rp_ + (size_t)i_ * ldp + (MODE == 0 ? 1024 : 512)); \
            if (MODE == 1) nl[i_] = *(const GAS unsigned*)(rp_ + (size_t)i_ * ldp + 3072); else nl[i_] = 0u; } } while (0)
    if (bid < nunits) LAP_FETCH(bid);
    for (int u = bid; u < nunits; u += G) {
        const int c = u & 127, h = (u >> 7) % H, b = (u >> 7) / H;
        const size_t row0 = (size_t)b * SEQ + (size_t)c * 64;
        const int qcol = h * 128, kcol = (MODE == 0 ? 1024 : 512) + h * 128;
        unsigned cq[8], ck[8], cl2[8];
#pragma unroll
        for (int i = 0; i < 8; ++i) { cq[i] = nq[i]; ck[i] = nk[i]; cl2[i] = nl[i]; }
        if (u + G < nunits) LAP_FETCH(u + G);
        const int ch0 = h * 128 + 2 * cp;
        float cc0 = 0.f, cc1 = 0.f;
        if (MODE == 0) {
#pragma unroll
            for (int e = 0; e < 2; ++e) { float v[5], mx = -1e30f;
#pragma unroll
                for (int q = 0; q < 5; ++q) { v[q] = lblg[q * DM + ch0 + e]; mx = fmaxf(mx, v[q]); }
                float den = 0.f, num = 0.f;
#pragma unroll
                for (int q = 0; q < 5; ++q) { const float ex = __expf(v[q] - mx); den += ex; if (q <= layer) num += ex; }
                const float lb = num / den; if (e == 0) cc0 = lb; else cc1 = lb; }
        } else { cc0 = gbg[ch0]; cc1 = gbg[ch0 + 1]; }
        float qv[8][2], kv[8][2], cl[8][2];
        float run0 = 0.f, run1 = 0.f;
#pragma unroll
        for (int i = 0; i < 8; ++i) { const int t = seg * 8 + i;
            const unsigned q2 = cq[i], k2 = ck[i];
            float g0, g1;
            if (MODE == 0) {
                qv[i][0] = silu(bflo(q2)); qv[i][1] = silu(bfhi(q2));
                const float f0 = cc0 + (1.0f - cc0) * sigm(bflo(k2)), f1 = cc1 + (1.0f - cc1) * sigm(bfhi(k2));
                kv[i][0] = 1.0f - f0; kv[i][1] = 1.0f - f1; g0 = __logf(f0); g1 = __logf(f1);
            } else {
                const unsigned l2 = cl2[i];
                qv[i][0] = bflo(q2); qv[i][1] = bfhi(q2); kv[i][0] = bflo(k2); kv[i][1] = bfhi(k2);
                const float z0 = bflo(l2) + cc0, z1 = bfhi(l2) + cc1;
                g0 = (fminf(z0, 0.f) - __logf(1.0f + __expf(-fabsf(z0)))) * 0.0625f; g1 = (fminf(z1, 0.f) - __logf(1.0f + __expf(-fabsf(z1)))) * 0.0625f;
            }
            run0 += g0; run1 += g1; cl[i][0] = run0; cl[i][1] = run1; }
        sTot[seg * 128 + 2 * cp] = run0; sTot[seg * 128 + 2 * cp + 1] = run1;
        __syncthreads();
        float pre0 = 0.f, pre1 = 0.f, ref0 = 0.f, ref1 = 0.f, last0 = 0.f, last1 = 0.f;
#pragma unroll
        for (int s = 0; s < 8; ++s) { const float a0 = sTot[s * 128 + 2 * cp], a1 = sTot[s * 128 + 2 * cp + 1];
            if (s < seg) { pre0 += a0; pre1 += a1; } if (s < 4) { ref0 += a0; ref1 += a1; } last0 += a0; last1 += a1; }
        unsigned kh0[4], kh1[4];
#pragma unroll
        for (int i = 0; i < 8; ++i) { const int t = seg * 8 + i;
            const float c0 = pre0 + cl[i][0], c1 = pre1 + cl[i][1];
            const float qs0 = qv[i][0] * scale, qs1 = qv[i][1] * scale;
            const float d0 = fminf(fmaxf(c0 - ref0, -80.f), 80.f), d1 = fminf(fmaxf(c1 - ref1, -80.f), 80.f);
            *(LAS unsigned*)(sQ + t * 136 + 2 * cp) = pkbf(qs0 * __expf(d0), qs1 * __expf(d1));
            *(LAS unsigned*)(sK + t * 136 + 2 * cp) = pkbf(kv[i][0] * __expf(-d0), kv[i][1] * __expf(-d1));
            *(GAS unsigned*)(Pg + (row0 + t) * ldp + qcol + 2 * cp) = pkbf(qs0 * __expf(c0), qs1 * __expf(c1));
            cl[i][0] = kv[i][0] * __expf(last0 - c0); cl[i][1] = kv[i][1] * __expf(last1 - c1); }
#pragma unroll
        for (int i = 0; i < 4; ++i) { kh0[i] = pkbf(cl[2 * i][0], cl[2 * i + 1][0]); kh1[i] = pkbf(cl[2 * i][1], cl[2 * i + 1][1]); }
        { GAS bf16_t* kp = Pg + (row0 + cp) * ldp + kcol + 8 * seg;
          *(GAS u32x4*)kp = (u32x4){kh0[0], kh0[1], kh0[2], kh0[3]}; *(GAS u32x4*)(kp + 64) = (u32x4){kh1[0], kh1[1], kh1[2], kh1[3]}; }
        if (seg == 0) { Dg[(size_t)u * 128 + 2 * cp] = __expf(last0); Dg[(size_t)u * 128 + 2 * cp + 1] = __expf(last1); }
        __syncthreads();
        { const int tt = wid >> 1;
#pragma unroll
          for (int sti = 0; sti < 2; ++sti) { const int st = 2 * (wid & 1) + sti;
            f32x4 acc = (f32x4){0.f, 0.f, 0.f, 0.f};
            if (st <= tt) {
#pragma unroll
                for (int ks = 0; ks < 4; ++ks) {
                    const bf16x8 a = *(const LAS bf16x8*)(sK + (st * 16 + l15) * 136 + ks * 32 + kq * 8);
                    const bf16x8 bq = *(const LAS bf16x8*)(sQ + (tt * 16 + l15) * 136 + ks * 32 + kq * 8);
                    acc = MFMA16(a, bq, acc); }
            }
            const int t = tt * 16 + l15, s0 = st * 16 + kq * 4;
            float v[4];
#pragma unroll
            for (int j = 0; j < 4; ++j) v[j] = (s0 + j <= t) ? acc[j] : 0.f;
            u32x2 w; w.x = pkbf(v[0], v[1]); w.y = pkbf(v[2], v[3]);
            *(GAS u32x2*)(Ag + (size_t)u * 4096 + t * 64 + s0) = w; } }
        __syncthreads();
    }
}

template <int MODE>
__device__ __forceinline__ void la_scan(const int tid, const int bid, const int G, unsigned char* lds, const bf16_t* P, const bf16_t* Ain, const float* dlast, bf16_t* O) {
    constexpr int H = MODE == 0 ? 8 : 4, ldp = MODE == 0 ? 4096 : 3584, DV = MODE == 0 ? 128 : 256, NVS = DV / 32;
    constexpr int BUF = 50176;
    const int lane = tid & 63, w = __builtin_amdgcn_readfirstlane(tid >> 6), l15 = lane & 15, kq = lane >> 4;
    const GAS bf16_t* Pg = (const GAS bf16_t*)P; const GAS bf16_t* Ag = (const GAS bf16_t*)Ain; const GAS float* Dg = (const GAS float*)dlast; GAS bf16_t* Og = (GAS bf16_t*)O;
    LAS unsigned char* l3 = (LAS unsigned char*)lds;
    LAS bf16_t* sS0 = (LAS bf16_t*)(l3 + 2 * BUF);
    constexpr int ntasks = NB * H * NVS;
    const int vcu = (G % 8 == 0) ? (bid % 8) * (G / 8) + bid / 8 : bid;
    for (int task = vcu; task < ntasks; task += G) {
        const int vs = task % NVS, h = (task / NVS) % H, b = task / (NVS * H);
        const int qcol = h * 128, kcol = (MODE == 0 ? 1024 : 512) + h * 128, vcol = (MODE == 0 ? 2048 : 1024) + h * DV + vs * 32, ocol = h * DV + vs * 32;
        const size_t u0 = (size_t)(b * H + h) * NCHUNK;
        const size_t rowb = (size_t)b * SEQ;
        __syncthreads();
        for (int i = tid; i < 32 * 136 / 2; i += 512) ((LAS unsigned*)sS0)[i] = 0u;
        u32x4 rA, rQ[2], rK[2]; u32x2 rV; float rD = 0.f;
#define LA_LOAD(c) do { const size_t r0_ = rowb + (size_t)(c) * 64; \
            rA = *(const GAS u32x4*)(Ag + (u0 + (c)) * 4096 + (tid >> 3) * 64 + (tid & 7) * 8); \
            _Pragma("unroll") for (int i_ = 0; i_ < 2; ++i_) { const int idx_ = tid + 512 * i_, r_ = idx_ >> 4, c8_ = (idx_ & 15) * 8; \
                rQ[i_] = *(const GAS u32x4*)(Pg + (r0_ + r_) * ldp + qcol + c8_); rK[i_] = *(const GAS u32x4*)(Pg + (r0_ + r_) * ldp + kcol + c8_); } \
            rV = *(const GAS u32x2*)(Pg + (r0_ + (tid >> 3)) * ldp + vcol + (tid & 7) * 4); \
            if (tid < 128) rD = Dg[(u0 + (c)) * 128 + tid]; } while (0)
#define LA_WRITE(buf) do { LAS unsigned char* bb_ = l3 + (buf) * BUF; LAS bf16_t* sA_ = (LAS bf16_t*)bb_; LAS bf16_t* sQ_ = (LAS bf16_t*)(bb_ + 9216); LAS bf16_t* sK_ = (LAS bf16_t*)(bb_ + 26624); LAS bf16_t* sV_ = (LAS bf16_t*)(bb_ + 45056); LAS float* sD_ = (LAS float*)(bb_ + 49664); \
            *(LAS u32x4*)(sA_ + (tid >> 3) * 72 + (tid & 7) * 8) = rA; \
            _Pragma("unroll") for (int i_ = 0; i_ < 2; ++i_) { const int idx_ = tid + 512 * i_, r_ = idx_ >> 4, c8_ = (idx_ & 15) * 8; \
                *(LAS u32x4*)(sQ_ + r_ * 136 + c8_) = rQ[i_]; *(LAS u32x4*)(sK_ + (2 * r_ + (c8_ >> 6)) * 72 + (c8_ & 63)) = rK[i_]; } \
            { const int s_ = tid >> 3, v4_ = (tid & 7) * 4; sV_[(v4_ + 0) * 72 + s_] = (bf16_t)(rV.x & 0xffffu); sV_[(v4_ + 1) * 72 + s_] = (bf16_t)(rV.x >> 16); \
              sV_[(v4_ + 2) * 72 + s_] = (bf16_t)(rV.y & 0xffffu); sV_[(v4_ + 3) * 72 + s_] = (bf16_t)(rV.y >> 16); } \
            if (tid < 128) sD_[tid] = rD; } while (0)
        LA_LOAD(0);
        LA_WRITE(0);
        __syncthreads();
        f32x4 st[2]; st[0] = (f32x4){0.f, 0.f, 0.f, 0.f}; st[1] = (f32x4){0.f, 0.f, 0.f, 0.f};
        const int tt = w >> 1, vt = w & 1;
        for (int c = 0; c < NCHUNK; ++c) {
            const int cur = c & 1;
            if (c + 1 < NCHUNK) LA_LOAD(c + 1);
            const LAS unsigned char* bb = l3 + cur * BUF;
            const LAS bf16_t* sS = sS0 + cur * (32 * 136); LAS bf16_t* sSn = sS0 + (cur ^ 1) * (32 * 136);
            const LAS bf16_t* sA = (const LAS bf16_t*)bb; const LAS bf16_t* sQ = (const LAS bf16_t*)(bb + 9216); const LAS bf16_t* sK = (const LAS bf16_t*)(bb + 26624); const LAS bf16_t* sV = (const LAS bf16_t*)(bb + 45056); const LAS float* sD = (const LAS float*)(bb + 49664);
            f32x4 o = (f32x4){0.f, 0.f, 0.f, 0.f};
#pragma unroll
            for (int ks = 0; ks < 2; ++ks) {
                const bf16x8 a = *(const LAS bf16x8*)(sV + (vt * 16 + l15) * 72 + ks * 32 + kq * 8);
                const bf16x8 bq = *(const LAS bf16x8*)(sA + (tt * 16 + l15) * 72 + ks * 32 + kq * 8);
                o = MFMA16(a, bq, o); }
#pragma unroll
            for (int ks = 0; ks < 4; ++ks) {
                const bf16x8 a = *(const LAS bf16x8*)(sS + (vt * 16 + l15) * 136 + ks * 32 + kq * 8);
                const bf16x8 bq = *(const LAS bf16x8*)(sQ + (tt * 16 + l15) * 136 + ks * 32 + kq * 8);
                o = MFMA16(a, bq, o); }
            { u32x2 wv; wv.x = pkbf(o[0], o[1]); wv.y = pkbf(o[2], o[3]);
              *(GAS u32x2*)(Og + (rowb + (size_t)c * 64 + tt * 16 + l15) * DM + ocol + vt * 16 + kq * 4) = wv; }
            const float dk = sD[w * 16 + l15];
#pragma unroll
            for (int v2 = 0; v2 < 2; ++v2) {
                st[v2] = st[v2] * dk;
#pragma unroll
                for (int ks = 0; ks < 2; ++ks) {
                    const bf16x8 a = *(const LAS bf16x8*)(sV + (v2 * 16 + l15) * 72 + ks * 32 + kq * 8);
                    const bf16x8 bk = *(const LAS bf16x8*)(sK + (w * 16 + l15) * 72 + ks * 32 + kq * 8);
                    st[v2] = MFMA16(a, bk, st[v2]); } }
#pragma unroll
            for (int v2 = 0; v2 < 2; ++v2) {
                const unsigned p01 = pkbf(st[v2][0], st[v2][1]), p23 = pkbf(st[v2][2], st[v2][3]);
                LAS bf16_t* sp = sSn + (v2 * 16 + kq * 4) * 136 + w * 16 + l15;
                sp[0] = (bf16_t)(p01 & 0xffffu); sp[136] = (bf16_t)(p01 >> 16); sp[272] = (bf16_t)(p23 & 0xffffu); sp[408] = (bf16_t)(p23 >> 16); }
            if (c + 1 < NCHUNK) LA_WRITE(cur ^ 1);
            __syncthreads();
        }
#undef LA_LOAD
#undef LA_WRITE
    }
}

template <int MODE>
__device__ __forceinline__ void la_post(const int tid, const int bid, const int G, bf16_t* O, const bf16_t* P, const float* gain) {
    constexpr int ldp = MODE == 0 ? 4096 : 3584, DV = MODE == 0 ? 128 : 256, GRP = DV / 16, gcol = MODE == 0 ? 3072 : 2048;
    const int lane = tid & 63, wid = __builtin_amdgcn_readfirstlane(tid >> 6);
    const int gw = bid * 8 + wid, NGW = G * 8;
    float gn[16];
#pragma unroll
    for (int e = 0; e < 16; ++e) gn[e] = gain[(lane % GRP) * 16 + e];
    for (int row = gw; row < M; row += NGW) {
        GAS bf16_t* op = (GAS bf16_t*)O + (size_t)row * DM + lane * 16; const GAS bf16_t* gp = (const GAS bf16_t*)P + (size_t)row * ldp + gcol + lane * 16;
        const u32x4 o0 = *(const GAS u32x4*)op, o1 = *(const GAS u32x4*)(op + 8), g0 = *(const GAS u32x4*)gp, g1 = *(const GAS u32x4*)(gp + 8);
        const float ov[16] = {bflo(o0.x), bfhi(o0.x), bflo(o0.y), bfhi(o0.y), bflo(o0.z), bfhi(o0.z), bflo(o0.w), bfhi(o0.w),
                              bflo(o1.x), bfhi(o1.x), bflo(o1.y), bfhi(o1.y), bflo(o1.z), bfhi(o1.z), bflo(o1.w), bfhi(o1.w)};
        const float gv[16] = {bflo(g0.x), bfhi(g0.x), bflo(g0.y), bfhi(g0.y), bflo(g0.z), bfhi(g0.z), bflo(g0.w), bfhi(g0.w),
                              bflo(g1.x), bfhi(g1.x), bflo(g1.y), bfhi(g1.y), bflo(g1.z), bfhi(g1.z), bflo(g1.w), bfhi(g1.w)};
        float ss = 0.f;
#pragma unroll
        for (int e = 0; e < 16; ++e) ss += ov[e] * ov[e];
#pragma unroll
        for (int off = 1; off < GRP; off <<= 1) ss += shx(ss, off, lane);
        const float r = rsqrtf(ss * (1.0f / DV) + EPS);
        float y[16];
#pragma unroll
        for (int e = 0; e < 16; ++e) y[e] = ov[e] * r * gn[e] * silu(gv[e]);
        u32x4 w0, w1; w0.x = pkbf(y[0], y[1]); w0.y = pkbf(y[2], y[3]); w0.z = pkbf(y[4], y[5]); w0.w = pkbf(y[6], y[7]);
        w1.x = pkbf(y[8], y[9]); w1.y = pkbf(y[10], y[11]); w1.z = pkbf(y[12], y[13]); w1.w = pkbf(y[14], y[15]);
        *(GAS u32x4*)op = w0; *(GAS u32x4*)(op + 8) = w1;
    }
}

__device__ __forceinline__ void attn_tile(const LAS bf16_t* kb, const LAS bf16_t* vb, const LAS float* sB, const bf16x8 (&qf)[2][2], f32x4 (&oacc)[4][2], float (&mrow)[2], float (&lrow)[2],
                                          const int kc, const int qpos0, const int lane, const int l15, const int kq) {
    f32x4 s[4][2];
#pragma unroll
    for (int kt = 0; kt < 4; ++kt) {
        const bf16x8 ka0 = *(const LAS bf16x8*)(kb + (kt * 16 + l15) * 72 + kq * 8), ka1 = *(const LAS bf16x8*)(kb + (kt * 16 + l15) * 72 + 32 + kq * 8);
#pragma unroll
        for (int qt = 0; qt < 2; ++qt) { f32x4 z = (f32x4){0.f, 0.f, 0.f, 0.f}; z = MFMA16(ka0, qf[qt][0], z); s[kt][qt] = MFMA16(ka1, qf[qt][1], z); } }
#pragma unroll
    for (int qt = 0; qt < 2; ++qt) {
        const int qp = qpos0 + qt * 16 + l15;
        float mx = -1e30f;
#pragma unroll
        for (int kt = 0; kt < 4; ++kt)
#pragma unroll
            for (int j = 0; j < 4; ++j) { int d = qp - (kc * 64 + kt * 16 + kq * 4 + j); d = d < -63 ? -63 : (d > 128 ? 128 : d);
                const float val = s[kt][qt][j] * 0.125f + sB[d + 63]; s[kt][qt][j] = val; mx = fmaxf(mx, val); }
        mx = xmax32(xmax16(mx));
        const float mnew = fmaxf(mrow[qt], mx), alpha = __expf(mrow[qt] - mnew); mrow[qt] = mnew;
        float ps = 0.f;
#pragma unroll
        for (int kt = 0; kt < 4; ++kt)
#pragma unroll
            for (int j = 0; j < 4; ++j) { const float pv = __expf(s[kt][qt][j] - mnew); s[kt][qt][j] = pv; ps += pv; }
        lrow[qt] = lrow[qt] * alpha + ps;
#pragma unroll
        for (int dt = 0; dt < 4; ++dt) oacc[dt][qt] = oacc[dt][qt] * alpha;
    }
#pragma unroll
    for (int kk = 0; kk < 2; ++kk) {
        bf16x8 pb[2];
#pragma unroll
        for (int qt = 0; qt < 2; ++qt) { const f32x4 a = s[2 * kk][qt], c2 = s[2 * kk + 1][qt];
            const u32x4 pw = (u32x4){pkbf(a[0], a[1]), pkbf(a[2], a[3]), pkbf(c2[0], c2[1]), pkbf(c2[2], c2[3])}; pb[qt] = __builtin_bit_cast(bf16x8, pw); }
#pragma unroll
        for (int dt = 0; dt < 4; ++dt) {
            const LAS bf16_t* vp = vb + (dt * 16 + l15) * 72 + kk * 32 + kq * 4;
            const u32x2 lo = *(const LAS u32x2*)vp, hi = *(const LAS u32x2*)(vp + 16);
            const bf16x8 va = __builtin_bit_cast(bf16x8, ((u32x4){lo.x, lo.y, hi.x, hi.y}));
            oacc[dt][0] = MFMA16(va, pb[0], oacc[dt][0]); oacc[dt][1] = MFMA16(va, pb[1], oacc[dt][1]); }
    }
}
__device__ __forceinline__ void attn_phase(const int tid, const int bid, const int G, unsigned char* lds, const bf16_t* P, const float* relb, bf16_t* O) {
    const int lane = tid & 63, w = __builtin_amdgcn_readfirstlane(tid >> 6), l15 = lane & 15, kq = lane >> 4;
    LAS bf16_t* sK = (LAS bf16_t*)(LAS unsigned char*)lds; LAS bf16_t* sV = sK + 2 * 64 * 72; LAS float* sB = (LAS float*)(sV + 2 * 64 * 72);
    constexpr int nunits = NB * 16 * 32, ldp = 3072;
    const GAS bf16_t* Pg = (const GAS bf16_t*)P; const GAS float* relg = (const GAS float*)relb; GAS bf16_t* Og = (GAS bf16_t*)O;
    const int skey = tid >> 3, sd8 = (tid & 7) * 8;
    const int vcu = (G % 8 == 0) ? (bid % 8) * (G / 8) + bid / 8 : bid;
    const int upb = (nunits + G - 1) / G;
    for (int u = vcu * upb; u < nunits && u < (vcu + 1) * upb; ++u) {
        const int qg = u & 31, h = (u >> 5) & 15, b = u >> 9;
        const int cw = qg * 4 + (w >> 1);
        const size_t seq0 = (size_t)b * SEQ;
        const int qpos0 = qg * 256 + w * 32;
        __syncthreads();
        if (tid < 192) sB[tid] = relg[h * 192 + tid];
        bf16x8 qf[2][2];
#pragma unroll
        for (int qt = 0; qt < 2; ++qt)
#pragma unroll
            for (int ks = 0; ks < 2; ++ks) qf[qt][ks] = *(const GAS bf16x8*)(Pg + (seq0 + qpos0 + qt * 16 + l15) * ldp + h * 64 + ks * 32 + kq * 8);
        f32x4 oacc[4][2];
#pragma unroll
        for (int dt = 0; dt < 4; ++dt) { oacc[dt][0] = (f32x4){0.f, 0.f, 0.f, 0.f}; oacc[dt][1] = (f32x4){0.f, 0.f, 0.f, 0.f}; }
        float mrow[2] = {-1e30f, -1e30f}, lrow[2] = {0.f, 0.f};
        const int kc0 = qg * 4 - 8 < 0 ? 0 : qg * 4 - 8, kc1 = qg * 4 + 3;
        u32x4 kA, vA, kB, vB;
#define AT_LOAD(KR, VR, kc) do { const GAS bf16_t* kp_ = Pg + (seq0 + (size_t)(kc) * 64 + skey) * ldp + 1024 + h * 64 + sd8; KR = *(const GAS u32x4*)kp_; VR = *(const GAS u32x4*)(kp_ + 1024); } while (0)
#define AT_WRITE(KR, VR, buf) do { LAS bf16_t* kb_ = sK + (buf) * 64 * 72; LAS bf16_t* vb_ = sV + (buf) * 64 * 72; *(LAS u32x4*)(kb_ + skey * 72 + sd8) = KR; \
            vb_[(sd8 + 0) * 72 + skey] = (bf16_t)(VR.x & 0xffffu); vb_[(sd8 + 1) * 72 + skey] = (bf16_t)(VR.x >> 16); vb_[(sd8 + 2) * 72 + skey] = (bf16_t)(VR.y & 0xffffu); vb_[(sd8 + 3) * 72 + skey] = (bf16_t)(VR.y >> 16); \
            vb_[(sd8 + 4) * 72 + skey] = (bf16_t)(VR.z & 0xffffu); vb_[(sd8 + 5) * 72 + skey] = (bf16_t)(VR.z >> 16); vb_[(sd8 + 6) * 72 + skey] = (bf16_t)(VR.w & 0xffffu); vb_[(sd8 + 7) * 72 + skey] = (bf16_t)(VR.w >> 16); } while (0)
#define AT_ITER(kc, KL, VL, KW, VW) do { const int cur_ = ((kc) - kc0) & 1; \
            if ((kc) + 2 <= kc1) AT_LOAD(KL, VL, (kc) + 2); \
            if ((kc) >= cw - 8 && (kc) <= cw) attn_tile(sK + cur_ * 64 * 72, sV + cur_ * 64 * 72, sB, qf, oacc, mrow, lrow, (kc), qpos0, lane, l15, kq); \
            if ((kc) + 1 <= kc1) AT_WRITE(KW, VW, cur_ ^ 1); \
            __syncthreads(); } while (0)
        AT_LOAD(kA, vA, kc0);
        AT_WRITE(kA, vA, 0);
        if (kc0 + 1 <= kc1) AT_LOAD(kA, vA, kc0 + 1);
        __syncthreads();
        for (int kc = kc0; kc <= kc1; kc += 2) {
            AT_ITER(kc, kB, vB, kA, vA);
            if (kc + 1 <= kc1) AT_ITER(kc + 1, kA, vA, kB, vB);
        }
#undef AT_LOAD
#undef AT_WRITE
#undef AT_ITER
#pragma unroll
        for (int qt = 0; qt < 2; ++qt) { float lt = xsum32(xsum16(lrow[qt])); const float inv = 1.0f / lt;
#pragma unroll
            for (int dt = 0; dt < 4; ++dt) { const f32x4 ov = oacc[dt][qt] * inv; u32x2 wv; wv.x = pkbf(ov[0], ov[1]); wv.y = pkbf(ov[2], ov[3]);
                *(GAS u32x2*)(Og + (seq0 + qpos0 + qt * 16 + l15) * DM + h * 64 + dt * 16 + kq * 4) = wv; } }
    }
}

__device__ __forceinline__ void conv_phase(const int tid, const int bid, const int G, const bf16_t* P, const float* cw, const float* cb, bf16_t* XC) {
    const int c8 = (tid & 127) * 8, tq = tid >> 7;
    float wgt[4][8], bias[8];
#pragma unroll
    for (int e = 0; e < 8; ++e) { bias[e] = cb[c8 + e];
#pragma unroll
        for (int j = 0; j < 4; ++j) wgt[j][e] = cw[j * DM + c8 + e]; }
    for (int tile = bid; tile < M / 64; tile += G) {
        const int t0 = tile * 64 + tq * 16, tin = t0 & (SEQ - 1);
        float xm[3][8];
#pragma unroll
        for (int k = 1; k <= 3; ++k) {
            if (tin - k >= 0) { const u32x4 r = *(const GAS u32x4*)((const GAS bf16_t*)P + (size_t)(t0 - k) * 2048 + 1024 + c8);
                xm[3 - k][0] = bflo(r.x); xm[3 - k][1] = bfhi(r.x); xm[3 - k][2] = bflo(r.y); xm[3 - k][3] = bfhi(r.y); xm[3 - k][4] = bflo(r.z); xm[3 - k][5] = bfhi(r.z); xm[3 - k][6] = bflo(r.w); xm[3 - k][7] = bfhi(r.w); }
            else {
#pragma unroll
                for (int e = 0; e < 8; ++e) xm[3 - k][e] = 0.f; } }
#pragma unroll 4
        for (int i = 0; i < 16; ++i) {
            const u32x4 r = *(const GAS u32x4*)((const GAS bf16_t*)P + (size_t)(t0 + i) * 2048 + 1024 + c8);
            const float xv[8] = {bflo(r.x), bfhi(r.x), bflo(r.y), bfhi(r.y), bflo(r.z), bfhi(r.z), bflo(r.w), bfhi(r.w)};
            float y[8];
#pragma unroll
            for (int e = 0; e < 8; ++e) { y[e] = bias[e] + wgt[0][e] * xm[0][e] + wgt[1][e] * xm[1][e] + wgt[2][e] * xm[2][e] + wgt[3][e] * xv[e];
                xm[0][e] = xm[1][e]; xm[1][e] = xm[2][e]; xm[2][e] = xv[e]; }
            u32x4 wv; wv.x = pkbf(y[0], y[1]); wv.y = pkbf(y[2], y[3]); wv.z = pkbf(y[4], y[5]); wv.w = pkbf(y[6], y[7]);
            *(GAS u32x4*)((GAS bf16_t*)XC + (size_t)(t0 + i) * DM + c8) = wv; }
    }
}
__device__ __forceinline__ void lru_scan1(const int tid, const int bid, const int G, bf16_t* GL, const bf16_t* XC, const float* ba, const float* bx, const float* lam, float* segS, float* segB) {
    const int c2 = tid * 2, col = 256 * (c2 >> 7) + (c2 & 127);
    const float ba0 = ba[c2], ba1 = ba[c2 + 1], bx0 = bx[c2], bx1 = bx[c2 + 1];
    const float sp0 = -8.0f * log1pf(expf(-lam[c2])), sp1 = -8.0f * log1pf(expf(-lam[c2 + 1]));
    for (int u = bid; u < NB * 64; u += G) {
        const size_t row0 = (size_t)(u >> 6) * SEQ + (size_t)(u & 63) * 128;
        float h0 = 0.f, h1 = 0.f, s0 = 0.f, s1 = 0.f;
#pragma unroll 8
        for (int i = 0; i < 128; ++i) { GAS bf16_t* gp = (GAS bf16_t*)GL + (row0 + i) * 2048 + col;
            const unsigned r2 = *(const GAS unsigned*)gp, i2 = *(const GAS unsigned*)(gp + 128), x2 = *(const GAS unsigned*)((const GAS bf16_t*)XC + (row0 + i) * DM + c2);
            const float l0 = sigm(bflo(r2) + ba0) * sp0, l1 = sigm(bfhi(r2) + ba1) * sp1;
            float m0 = __builtin_amdgcn_sqrtf(fmaxf(1.0f - __expf(2.0f * l0), 0.0f)), m1 = __builtin_amdgcn_sqrtf(fmaxf(1.0f - __expf(2.0f * l1), 0.0f));
            if ((u & 63) == 0 && i == 0) { m0 = 1.0f; m1 = 1.0f; }
            const unsigned lp = pkbf(l0, l1), bp = pkbf(m0 * sigm(bflo(i2) + bx0) * bflo(x2), m1 * sigm(bfhi(i2) + bx1) * bfhi(x2));
            *(GAS unsigned*)gp = lp; *(GAS unsigned*)(gp + 128) = bp;
            const float q0 = bflo(lp), q1 = bfhi(lp);
            h0 = __expf(q0) * h0 + bflo(bp); h1 = __expf(q1) * h1 + bfhi(bp); s0 += q0; s1 += q1; }
        *(GAS f32x2_t*)((GAS float*)segS + (size_t)u * DM + c2) = (f32x2_t){s0, s1}; *(GAS f32x2_t*)((GAS float*)segB + (size_t)u * DM + c2) = (f32x2_t){h0, h1};
    }
}
__device__ __forceinline__ void lru_scan2(const int tid, const int bid, const int G, const bf16_t* GL, const float* segS, const float* segB, const bf16_t* P, bf16_t* Y) {
    const int c2 = tid * 2, col = 256 * (c2 >> 7) + (c2 & 127);
    for (int u = bid; u < NB * 64; u += G) {
        const int b = u >> 6, seg = (u & 256) ? 63 - (u & 63) : (u & 63);
        const size_t row0 = (size_t)b * SEQ + (size_t)seg * 128;
        float h0 = 0.f, h1 = 0.f;
#pragma unroll 8
        for (int s = 0; s < seg; ++s) { const f32x2_t ss = *(const GAS f32x2_t*)((const GAS float*)segS + (size_t)(b * 64 + s) * DM + c2), sb = *(const GAS f32x2_t*)((const GAS float*)segB + (size_t)(b * 64 + s) * DM + c2);
            h0 = __expf(ss.x) * h0 + sb.x; h1 = __expf(ss.y) * h1 + sb.y; }
#pragma unroll 8
        for (int i = 0; i < 128; ++i) { const GAS bf16_t* gp = (const GAS bf16_t*)GL + (row0 + i) * 2048 + col; const unsigned a2 = *(const GAS unsigned*)gp, b2 = *(const GAS unsigned*)(gp + 128), y2 = *(const GAS unsigned*)((const GAS bf16_t*)P + (row0 + i) * 2048 + c2);
            h0 = __expf(bflo(a2)) * h0 + bflo(b2); h1 = __expf(bfhi(a2)) * h1 + bfhi(b2);
            const float y0 = bflo(y2), y1 = bfhi(y2);
            const float g0 = y0 * sigm(1.5957691216057308f * (y0 + 0.044715f * y0 * y0 * y0)), g1 = y1 * sigm(1.5957691216057308f * (y1 + 0.044715f * y1 * y1 * y1));
            *(GAS unsigned*)((GAS bf16_t*)Y + (row0 + i) * DM + c2) = pkbf(g0 * h0, g1 * h1); }
    }
}

#define XB_TMO      128
#define XB_XCNT(j)  (256  + 64 * (j))
#define XB_XSUB(j)  (1280 + 64 * (j))
#define XB_XGEN(j)  (2304 + 64 * (j))
#define XB_TOP      3328
#define XB_TOPGEN   3392
#define XCD_BAR_WORDS 3456
#define XB_SPIN_CAP (1u << 22)
__device__ __forceinline__ unsigned xb_ld(unsigned* p)              { return __hip_atomic_load(p, __ATOMIC_RELAXED, __HIP_MEMORY_SCOPE_AGENT); }
__device__ __forceinline__ unsigned xb_add(unsigned* p, unsigned v) { return __hip_atomic_fetch_add(p, v, __ATOMIC_RELAXED, __HIP_MEMORY_SCOPE_AGENT); }
__device__ __forceinline__ unsigned xb_xcc_id() { return (unsigned)__builtin_amdgcn_s_getreg((3 << 11) | 20) & 0xFu; }
#define XB_SPIN(cond, bar) do { unsigned _sp = 0; while (cond) { __builtin_amdgcn_s_sleep(1); \
    if ((++_sp & 255u) == 0u) { if (xb_ld(&(bar)[XB_TMO])) break; if (_sp > XB_SPIN_CAP) { atomicAdd(&(bar)[XB_TMO], 1u); break; } } } } while (0)
struct XcdBarrier { unsigned* bar; unsigned x; volatile LAS unsigned* st; };
__device__ __forceinline__ void xcd_barrier_complete(unsigned* bar, unsigned x, unsigned& nloc, unsigned& nx) {
    const unsigned G = gridDim.x * gridDim.y * gridDim.z;
    unsigned sum, cnt, mine, sp = 0u;
    for (;;) {
        sum = 0u; cnt = 0u; mine = 0u;
#pragma unroll
        for (unsigned j = 0; j < 16; ++j) { const unsigned c = xb_ld(&bar[XB_XCNT(j)]); sum += c; cnt += (c > 0u) ? 1u : 0u; mine = (j == x) ? c : mine; }
        if (sum == G) break;
        __builtin_amdgcn_s_sleep(1);
        if ((++sp & 255u) == 0u) { if (xb_ld(&bar[XB_TMO])) break; if (sp > XB_SPIN_CAP) { atomicAdd(&bar[XB_TMO], 1u); break; } }
    }
    nloc = mine > 0u ? mine : 1u; nx = cnt > 0u ? cnt : 1u;
}
__device__ __forceinline__ void xcd_barrier(const XcdBarrier& b) {
    asm volatile("s_waitcnt vmcnt(0)" ::: "memory");
    __syncthreads();
    if (threadIdx.x == 0) {
        unsigned* bar = b.bar;
        __builtin_amdgcn_s_waitcnt(0);
        unsigned nloc = b.st[0], nx = b.st[1];
        if (nloc == 0u) { xcd_barrier_complete(bar, b.x, nloc, nx); b.st[0] = nloc; b.st[1] = nx; }
        const unsigned old = xb_add(&bar[XB_XSUB(b.x)], 1u);
        const unsigned gen = old / nloc;
        if (old + 1u == (gen + 1u) * nloc) {
            __builtin_amdgcn_fence(__ATOMIC_RELEASE, "agent");
            asm volatile("s_waitcnt vmcnt(0)" ::: "memory");
            const unsigned og = xb_add(&bar[XB_TOP], 1u);
            const unsigned tg = og / nx;
            if (og + 1u == (tg + 1u) * nx) xb_add(&bar[XB_TOPGEN], 1u);
            else XB_SPIN(xb_ld(&bar[XB_TOPGEN]) == tg, bar);
            __builtin_amdgcn_fence(__ATOMIC_ACQUIRE, "agent");
            xb_add(&bar[XB_XGEN(b.x)], 1u);
            asm volatile("s_waitcnt vmcnt(0)" ::: "memory");
        } else {
            XB_SPIN(xb_ld(&bar[XB_XGEN(b.x)]) == gen, bar);
            __builtin_amdgcn_fence(__ATOMIC_ACQUIRE, "agent");
            asm volatile("s_waitcnt vmcnt(0)" ::: "memory");
        }
    }
    __syncthreads();
}

enum { K_WEIGHTS = 0, K_NORM, K_G_SWIGLU, K_G_RESID, K_G_STORE, K_LA_PREP, K_LA_SCAN, K_LA_POST, K_ATTN, K_CONV, K_SCAN1, K_SCAN2, K_FINAL };
constexpr int NPH = 1 + (7 + 5) + (7 + 5) + (7 + 3) + (7 + 6) + 1;

__device__ __forceinline__ const float* inp(const Params& p, int k) { asm volatile("" : "+s"(k)); return (const float*)(const GAS float*)p.in[k]; }

__global__ void __launch_bounds__(512, 2) fwd_kernel(Params p) {
    extern __shared__ __attribute__((aligned(16))) unsigned char lds_raw[];
    unsigned char* lds = lds_raw;
    LAS unsigned char* lds3 = (LAS unsigned char*)lds_raw;
    const int wid_root = __builtin_amdgcn_readfirstlane(threadIdx.x >> 6);
    if (threadIdx.x < 2) ((volatile LAS unsigned*)(lds3 + LDS_BAR))[threadIdx.x] = 0u;
    if (threadIdx.x == 0) (void)xb_add(&((unsigned*)p.ws)[XB_XCNT(xb_xcc_id())], 1u);
    __syncthreads();
    for (int ph = p.ph_lo; ph < p.ph_hi; ++ph) {
        int wq = wid_root; asm volatile("" : "+s"(wq));
        int lane_; asm volatile("v_mbcnt_lo_u32_b32 %0, -1, 0\n\tv_mbcnt_hi_u32_b32 %0, -1, %0" : "=v"(lane_));
        const int tid = wq * 64 + lane_;
        int bid = blockIdx.x; asm volatile("" : "+s"(bid));
        int G = gridDim.x; asm volatile("" : "+s"(G));
        unsigned char* ws = p.ws; asm volatile("" : "+s"(ws)); ws = (unsigned char*)(GAS unsigned char*)ws;
        float* xout = p.out; asm volatile("" : "+s"(xout)); xout = (float*)(GAS float*)xout;
        bf16_t* Hb = (bf16_t*)(ws + WS_H);
        bf16_t* R1 = (bf16_t*)(ws + WS_R1);
        bf16_t* XR = (bf16_t*)(ws + WS_XR);
        float* SSP = (float*)(ws + WS_SSP);
        float* RSTD = (float*)(ws + WS_RSTD);
        int kind = K_FINAL, L = 0, sub = 0;
        if (ph == 0) kind = K_WEIGHTS;
        else { int q = ph - 1;
            for (int l = 0; l < 4; ++l) { const int cn = (l == 0 || l == 1) ? 12 : (l == 2 ? 10 : 13); if (q < cn) { L = l; sub = q; kind = -1; break; } q -= cn; } }
        int ffn = 0, nidx = 0, mix = -1, msub = 0;
        if (kind == -1) {
            const int mc = (L == 2) ? 3 : (L == 3 ? 6 : 5);
            if (sub == 0) { kind = K_NORM; nidx = 0; }
            else if (sub == 1) { kind = K_G_SWIGLU; ffn = 2 * L; }
            else if (sub == 2) { kind = K_G_RESID; ffn = 2 * L; }
            else if (sub == 3) { kind = K_NORM; nidx = 1; }
            else if (sub < 4 + mc) { mix = L; msub = sub - 4;
                if (L == 0 || L == 1) kind = msub == 0 ? K_G_STORE : msub == 1 ? K_LA_PREP : msub == 2 ? K_LA_SCAN : msub == 3 ? K_LA_POST : K_G_RESID;
                else if (L == 2) kind = msub == 0 ? K_G_STORE : msub == 1 ? K_ATTN : K_G_RESID;
                else kind = msub == 0 ? K_G_STORE : msub == 1 ? K_CONV : msub == 2 ? K_G_STORE : msub == 3 ? K_SCAN1 : msub == 4 ? K_SCAN2 : K_G_RESID; }
            else { const int s2 = sub - 4 - mc; if (s2 == 0) { kind = K_NORM; nidx = 2; } else if (s2 == 1) { kind = K_G_SWIGLU; ffn = 2 * L + 1; } else { kind = K_G_RESID; ffn = 2 * L + 1; } }
        }
        if (kind == K_NORM && L == 0 && nidx == 0) continue;
        switch (kind) {
        case K_WEIGHTS: weights_phase(tid, bid, G, p, ws, lds); first_phase(tid, bid, G, inp(p, 0), XR, RSTD); break;
        case K_NORM: rstd_phase(tid, bid, G, SSP, RSTD); break;
        case K_FINAL: final_phase(tid, bid, G, XR, SSP, xout, inp(p, 4)); break;
        case K_G_SWIGLU: {
            pg8::Gemm g{XR, (const bf16_t*)(ws + WS_W + ffn * FFN_STRIDE), M, 2 * FF, DM, DM, 0};
            pg8::StaticOrder S; S.init(M, 2 * FF, G, bid);
            pg8::EpiSwiGLU E{R1, RSTD};
            pg8::gemm_phase<pg8::EpiSwiGLU>(tid, lds3, g, S, E);
        } break;
        case K_G_RESID: {
            pg8::Gemm g; float scale;
            if (mix < 0) { g = pg8::Gemm{R1, (const bf16_t*)(ws + WS_W + ffn * FFN_STRIDE + WD_OFF), M, DM, FF, FF, 0}; scale = 0.5f; }
            else { const size_t wo = mix == 0 ? WS_HG_OUT : mix == 1 ? WS_GL_OUT : mix == 2 ? WS_AT_OUT : WS_LR_OUT; g = pg8::Gemm{Hb, (const bf16_t*)(ws + wo), M, DM, DM, DM, 0}; scale = 1.0f; }
            pg8::StaticOrder S; S.init(M, DM, G, bid);
            pg8::EpiResid E{XR, scale, SSP, nullptr};
            pg8::gemm_phase<pg8::EpiResid>(tid, lds3, g, S, E);
        } break;
        case K_G_STORE: {
            const bool gate = (mix == 3 && msub == 2);
            const int N = mix == 0 ? 4096 : mix == 1 ? 3584 : mix == 2 ? 3072 : 2048;
            const size_t wi = mix == 0 ? WS_HG_IN : mix == 1 ? WS_GL_IN : mix == 2 ? WS_AT_IN : (gate ? WS_LR_GATE : WS_LR_IN);
            pg8::Gemm g{gate ? Hb : XR, (const bf16_t*)(ws + wi), M, N, gate ? 256 : DM, DM, gate ? 2 : 0};
            pg8::StaticOrder S; S.init(M, N, G, bid);
            pg8::EpiStore E{gate ? R1 + (size_t)M * 2048 : R1, N, gate ? (const float*)nullptr : (const float*)RSTD};
            pg8::gemm_phase<pg8::EpiStore>(tid, lds3, g, S, E);
        } break;
        case K_LA_PREP:
            if (mix == 0) la_prep<0>(tid, bid, G, lds, R1, inp(p, 6), L, nullptr, (bf16_t*)(ws + WS_R2), (float*)(ws + WS_DL));
            else la_prep<1>(tid, bid, G, lds, R1, nullptr, L, inp(p, 12), (bf16_t*)(ws + WS_R2), (float*)(ws + WS_DL));
            break;
        case K_LA_SCAN:
            if (mix == 0) la_scan<0>(tid, bid, G, lds, R1, (const bf16_t*)(ws + WS_R2), (const float*)(ws + WS_DL), Hb);
            else la_scan<1>(tid, bid, G, lds, R1, (const bf16_t*)(ws + WS_R2), (const float*)(ws + WS_DL), Hb);
            break;
        case K_LA_POST:
            if (mix == 0) la_post<0>(tid, bid, G, Hb, R1, inp(p, 7)); else la_post<1>(tid, bid, G, Hb, R1, inp(p, 13));
            break;
        case K_ATTN: attn_phase(tid, bid, G, lds, R1, inp(p, 16), Hb); break;
        case K_CONV: conv_phase(tid, bid, G, R1, inp(p, 19), inp(p, 20), Hb); break;
        case K_SCAN1: lru_scan1(tid, bid, G, R1 + (size_t)M * 2048, Hb, inp(p, 22), inp(p, 24), inp(p, 25), (float*)(ws + WS_R2), (float*)(ws + WS_R2 + 4 * MiB)); break;
        case K_SCAN2: lru_scan2(tid, bid, G, R1 + (size_t)M * 2048, (const float*)(ws + WS_R2), (const float*)(ws + WS_R2 + 4 * MiB), R1, Hb); break;
        default: break;
        }
        if (ph + 1 < p.ph_hi) {
            if (ph == p.ph_lo) cg::this_grid().sync();
            else { XcdBarrier xb; xb.bar = (unsigned*)ws; xb.x = xb_xcc_id(); xb.st = (volatile LAS unsigned*)(lds3 + LDS_BAR); xcd_barrier(xb); }
        }
    }
}

extern "C" void kernel_launch(void* const* d_in, const int* in_sizes, int n_in, void* d_out, int out_size, void* d_ws, size_t ws_size, hipStream_t stream) {
    static int grid = 0;
    if (grid == 0) {
        if (n_in != 27 || out_size != M * DM || ws_size < WS_END) { fprintf(stderr, "kernel_launch: unexpected sizes (n_in %d, out %d, ws %zu; need ws >= %zu); nothing launched\n", n_in, out_size, ws_size, (size_t)WS_END); grid = -1; return; }
        int dev = 0, cus = 0, per_cu = 0;
        if (hipGetDevice(&dev) != hipSuccess || hipDeviceGetAttribute(&cus, hipDeviceAttributeMultiprocessorCount, dev) != hipSuccess) { grid = -1; return; }
        if (hipFuncSetAttribute((const void*)fwd_kernel, hipFuncAttributeMaxDynamicSharedMemorySize, LDS_BYTES) != hipSuccess) { fprintf(stderr, "kernel_launch: hipFuncSetAttribute failed\n"); grid = -1; return; }
        if (hipOccupancyMaxActiveBlocksPerMultiprocessor(&per_cu, (const void*)fwd_kernel, 512, LDS_BYTES) != hipSuccess || per_cu < 1) { fprintf(stderr, "kernel_launch: occupancy query says %d blocks per CU\n", per_cu); per_cu = 1; }
        (void)hipGetLastError();
        grid = cus;
    }
    if (grid < 0) return;
    if (hipMemsetAsync(d_ws, 0, 16384, stream) != hipSuccess) { fprintf(stderr, "kernel_launch: memset of the barrier words failed\n"); return; }
    Params p{};
    for (int i = 0; i < 27; ++i) p.in[i] = (const float*)d_in[i];
    p.out = (float*)d_out; p.ws = (unsigned char*)d_ws;
#if ONE_LAUNCH
    p.ph_lo = 0; p.ph_hi = NPH;
    void* args[] = {&p};
    hipError_t e = hipLaunchCooperativeKernel((const void*)fwd_kernel, dim3(grid), dim3(512), args, LDS_BYTES, stream);
    if (e != hipSuccess) fprintf(stderr, "kernel_launch: cooperative launch failed: %s (grid %d)\n", hipGetErrorString(e), grid);
#else
    for (int ph = 0; ph < NPH; ++ph) { p.ph_lo = ph; p.ph_hi = ph + 1; hipLaunchKernelGGL(fwd_kernel, dim3(grid), dim3(512), LDS_BYTES, stream, p); }
#endif
}
```

```cpp
#include <hip/hip_runtime.h>
#include <hip/hip_cooperative_groups.h>
#include <cstdio>
#include <cstdint>
namespace cg = cooperative_groups;

#ifndef ONE_LAUNCH
#define ONE_LAUNCH 1
#endif

#define LAS __attribute__((address_space(3)))
#define GAS __attribute__((address_space(1)))
typedef unsigned short bf16_t;
typedef short bf16x8 __attribute__((ext_vector_type(8)));
typedef float f32x4 __attribute__((ext_vector_type(4)));
typedef unsigned u32x4 __attribute__((ext_vector_type(4)));
typedef unsigned u32x2 __attribute__((ext_vector_type(2)));

constexpr int M = 65536, DM = 1024, FF = 2816, SEQ = 8192, NB = 8, NCHUNK = 128;
constexpr float EPS = 1e-6f;

constexpr size_t MiB = (size_t)1 << 20;
constexpr size_t WS_W = 2 * MiB;
constexpr size_t FFN_STRIDE = 17301504;
constexpr size_t WD_OFF = 11 * MiB;
constexpr size_t WS_HG_IN = 134 * MiB, WS_HG_OUT = 142 * MiB, WS_GL_IN = 144 * MiB, WS_GL_OUT = 151 * MiB, WS_AT_IN = 153 * MiB, WS_AT_OUT = 159 * MiB,
                 WS_LR_IN = 161 * MiB, WS_LR_GATE = 165 * MiB, WS_LR_OUT = 166 * MiB;
constexpr size_t WS_H = 168 * MiB;
constexpr size_t WS_R1 = 296 * MiB;
constexpr size_t WS_R2 = 808 * MiB;
constexpr size_t WS_DL = 872 * MiB;
constexpr size_t WS_XR = 876 * MiB;
constexpr size_t WS_SSP = 1004 * MiB;
constexpr size_t WS_RSTD = 1008 * MiB;
constexpr size_t WS_END = 1009 * MiB;
constexpr int LDS_STAT = 131072;
constexpr int LDS_BAR = 131072 + 2048;
constexpr int LDS_BYTES = 131072 + 2048 + 64;

__device__ __forceinline__ float bflo(unsigned u) { return __uint_as_float(u << 16); }
__device__ __forceinline__ float bfhi(unsigned u) { return __uint_as_float(u & 0xffff0000u); }
typedef float f32x2_t __attribute__((ext_vector_type(2)));
typedef __bf16 bf16x2_t __attribute__((ext_vector_type(2)));
__device__ __forceinline__ unsigned pkbf(float lo, float hi) { const f32x2_t v = {lo, hi}; const bf16x2_t b = __builtin_convertvector(v, bf16x2_t); return __builtin_bit_cast(unsigned, b); }
__device__ __forceinline__ float frcp(float x) { return __builtin_amdgcn_rcpf(x); }
__device__ __forceinline__ float sigm(float x) { return frcp(1.0f + __expf(-x)); }
__device__ __forceinline__ float silu(float x) { return x * sigm(x); }
__device__ __forceinline__ float shx(float v, int off, int lane) { return __int_as_float(__builtin_amdgcn_ds_bpermute((lane ^ off) << 2, __float_as_int(v))); }
__device__ __forceinline__ float wave_sum(float v, int lane) {
#pragma unroll
    for (int o = 1; o < 64; o <<= 1) v += shx(v, o, lane);
    return v;
}
#define MFMA16(a, b, c) __builtin_amdgcn_mfma_f32_16x16x32_bf16((a), (b), (c), 0, 0, 0)

namespace pg8 {
constexpr int BM = 256, BK = 64, HALF = 128, HTB = HALF * BK * 2, STAGE_BYTES = 8 * HTB, NXCD = 8, WGM = 8;
__host__ __device__ __forceinline__ int lds_byte(int r, int c) { const int st = (r >> 4) * 2 + (c >> 5), rr = r & 15, cc = c & 31, ob = rr * 64 + cc * 2; return st * 1024 + (ob ^ (((ob >> 9) & 1) << 5)); }
__host__ __device__ __forceinline__ void stage_rc(int b, int& R, int& C) { const int st = b / 1024, sb = b % 1024, swz = sb ^ (((sb >> 9) & 1) << 5); R = (st >> 1) * 16 + swz / 64; C = (st & 1) * 32 + (swz % 64) / 2; }
__host__ __device__ __forceinline__ int perm32(int rho) { const int n = rho >> 4, i = rho & 15; return 8 * (i >> 2) + 4 * n + (i & 3); }

struct Unit { int pm, pn; };
struct Gemm { const bf16_t* A; const bf16_t* Bt; int M, N, K, lda, acol_div; };

struct StaticOrder {
    int nM, nN, nwg, G, c;
    __device__ void init(int M_, int N_, int G_, int c_) { nM = M_ / BM; nN = N_ / BM; nwg = nM * nN; G = G_; c = c_; }
    __device__ bool next(int i, Unit& u) const {
        const long L = (long)i * G + c; if (L >= nwg) return false;
        int wgid = (int)L; { const int q = nwg / NXCD, r = nwg % NXCD, xcd = wgid % NXCD, off = wgid / NXCD; wgid = (xcd < r ? xcd * (q + 1) : r * (q + 1) + (xcd - r) * q) + off; }
        const int nig = WGM * nN, gid = wgid / nig, fm = gid * WGM, gsz = (nM - fm) < WGM ? (nM - fm) : WGM;
        u.pm = fm + ((wgid % nig) % gsz); u.pn = (wgid % nig) / gsz; return true;
    }
};


struct EpiStore {
    static constexpr bool HAS_RS = true;
    bf16_t* O; int ldc; const float* rstd;
    __device__ __forceinline__ void operator()(const f32x4 (&acc)[2][2][4][2], const Unit& u, int wr, int wc, int fr, int fq, LAS unsigned char* lds, int par) const {
        asm volatile("" : "+v"(fr), "+v"(fq));
        const int row0 = u.pm * BM + wr * 64 + fr, col0 = u.pn * BM + wc * 32 + 8 * fq;
#pragma unroll
        for (int ai = 0; ai < 2; ++ai)
#pragma unroll
            for (int m = 0; m < 4; ++m) { GAS bf16_t* rowp = (GAS bf16_t*)O + (size_t)(row0 + ai * HALF + m * 16) * ldc + col0;
                const float rs = rstd ? ((const LAS float*)(lds + LDS_STAT))[par * 256 + wr * 64 + fr + ai * HALF + m * 16] : 1.0f;
#pragma unroll
                for (int bj = 0; bj < 2; ++bj) { const f32x4 v0 = acc[ai][bj][m][0] * rs, v1 = acc[ai][bj][m][1] * rs;
                    u32x4 w; w.x = pkbf(v0[0], v0[1]); w.y = pkbf(v0[2], v0[3]); w.z = pkbf(v1[0], v1[1]); w.w = pkbf(v1[2], v1[3]);
                    *(GAS u32x4*)(rowp + bj * HALF) = w; } }
    }
};
struct EpiSwiGLU {
    static constexpr bool HAS_RS = true;
    bf16_t* O; const float* rstd;
    __device__ __forceinline__ void operator()(const f32x4 (&acc)[2][2][4][2], const Unit& u, int wr, int wc, int fr, int fq, LAS unsigned char* lds, int par) const {
        asm volatile("" : "+v"(fr), "+v"(fq));
        const int row0 = u.pm * BM + wr * 64 + fr, col0 = u.pn * HALF + wc * 32 + 8 * fq;
#pragma unroll
        for (int ai = 0; ai < 2; ++ai)
#pragma unroll
            for (int m = 0; m < 4; ++m) { GAS bf16_t* rowp = (GAS bf16_t*)O + (size_t)(row0 + ai * HALF + m * 16) * FF + col0;
                const float rs = ((const LAS float*)(lds + LDS_STAT))[par * 256 + wr * 64 + fr + ai * HALF + m * 16];
                unsigned r[4];
#pragma unroll
                for (int n = 0; n < 2; ++n)
#pragma unroll
                    for (int j = 0; j < 4; j += 2) {
                        const f32x2_t g2 = (f32x2_t){acc[ai][0][m][n][j], acc[ai][0][m][n][j + 1]} * rs, u2 = (f32x2_t){acc[ai][1][m][n][j], acc[ai][1][m][n][j + 1]} * rs;
                        const f32x2_t t = g2 * -1.4426950408889634f; f32x2_t e; e.x = __builtin_amdgcn_exp2f(t.x); e.y = __builtin_amdgcn_exp2f(t.y);
                        const f32x2_t d = e + 1.0f; f32x2_t q; q.x = __builtin_amdgcn_rcpf(d.x); q.y = __builtin_amdgcn_rcpf(d.y);
                        const f32x2_t o = (g2 * u2) * q; r[n * 2 + (j >> 1)] = pkbf(o.x, o.y); }
                u32x4 w; w.x = r[0]; w.y = r[1]; w.z = r[2]; w.w = r[3];
                *(GAS u32x4*)rowp = w; }
    }
};
struct EpiResid {
    static constexpr bool HAS_RS = false;
    bf16_t* X; float scale; float* ssp; const float* rstd;
    __device__ __forceinline__ void operator()(const f32x4 (&acc)[2][2][4][2], const Unit& u, int wr, int wc, int fr, int fq, LAS unsigned char* lds, int par) const {
        asm volatile("" : "+v"(fr), "+v"(fq));
        const int row0 = u.pm * BM + wr * 64 + fr, col0 = u.pn * BM + wc * 32 + 8 * fq, lane = fq * 16 + fr;
        GAS float* sslot = (GAS float*)ssp + (size_t)(u.pn * 4 + wc) * M;
#pragma unroll
        for (int ai = 0; ai < 2; ++ai) {
            GAS bf16_t* base = (GAS bf16_t*)X + (size_t)(row0 + ai * HALF) * DM + col0;
            u32x4 xv[4][2];
#pragma unroll
            for (int m = 0; m < 4; ++m)
#pragma unroll
                for (int bj = 0; bj < 2; ++bj) xv[m][bj] = *(const GAS u32x4*)(base + (size_t)m * 16 * DM + bj * HALF);
            asm volatile("" ::: "memory");
#pragma unroll
            for (int m = 0; m < 4; ++m) { float sq = 0.f;
#pragma unroll
                for (int bj = 0; bj < 2; ++bj) { const u32x4 x = xv[m][bj]; const f32x4 a0 = acc[ai][bj][m][0] * scale, a1 = acc[ai][bj][m][1] * scale;
                    u32x4 w; w.x = pkbf(bflo(x.x) + a0[0], bfhi(x.x) + a0[1]); w.y = pkbf(bflo(x.y) + a0[2], bfhi(x.y) + a0[3]);
                    w.z = pkbf(bflo(x.z) + a1[0], bfhi(x.z) + a1[1]); w.w = pkbf(bflo(x.w) + a1[2], bfhi(x.w) + a1[3]);
                    *(GAS u32x4*)(base + (size_t)m * 16 * DM + bj * HALF) = w;
                    const float e0 = bflo(w.x), e1 = bfhi(w.x), e2 = bflo(w.y), e3 = bfhi(w.y), e4 = bflo(w.z), e5 = bfhi(w.z), e6 = bflo(w.w), e7 = bfhi(w.w);
                    sq += ((e0 * e0 + e1 * e1) + (e2 * e2 + e3 * e3)) + ((e4 * e4 + e5 * e5) + (e6 * e6 + e7 * e7)); }
                sq += shx(sq, 16, lane); sq += shx(sq, 32, lane);
                if (fq == 0) sslot[row0 + ai * HALF + m * 16] = sq; }
            asm volatile("" ::: "memory");
        }
    }
};
template <class Epi>
__device__ __forceinline__ void gemm_phase(const int tid, LAS unsigned char* lds, const Gemm g, const StaticOrder& S, const Epi& E) {
    const int wid = __builtin_amdgcn_readfirstlane(tid >> 6), lane = tid & 63, wr = wid >> 2, wc = wid & 3, fr = lane & 15, fq = lane >> 4;
    const int K = g.K, nt = K / BK, lda = g.lda;
    unsigned voffA[2], voffB[2];
#pragma unroll
    for (int i = 0; i < 2; ++i) { int R, C; stage_rc(tid * 16 + i * 8192, R, C); const int Rb = (R & ~31) + perm32(R & 31);
        voffA[i] = (unsigned)(R * lda + C) * 2u; voffB[i] = (unsigned)(Rb * K + C) * 2u; }
    const size_t kstep = (size_t)(BK * 2);
    const size_t hstepA = (size_t)HALF * lda * 2, hstepB = (size_t)HALF * K * 2;
    const size_t tstepA = 2 * hstepA, tstepB = 2 * hstepB;
    const unsigned ldsw = (unsigned)wid * 1024u;
    const int aoff = lds_byte(wr * 64 + fr, fq * 8), boff = lds_byte(wc * 32 + fr, fq * 8);
#define PG8_SA(b, h) (((b) * 2 + (h)) * HTB)
#define PG8_SB(b, h) ((4 + (b) * 2 + (h)) * HTB)
#define PG8_STAGE(bufoff, gbase, voff) do { _Pragma("unroll") for (int _i = 0; _i < 2; ++_i) \
        __builtin_amdgcn_global_load_lds((const unsigned*)((const char*)(gbase) + (voff)[_i]), (LAS unsigned*)(lds + (bufoff) + ldsw + _i * 8192), 16, 0, 0); } while (0)
#define PG8_LDA(dst, b, h) do { _Pragma("unroll") for (int m = 0; m < 4; ++m) _Pragma("unroll") for (int k = 0; k < 2; ++k) dst[m][k] = *(const LAS bf16x8*)(lds + PG8_SA(b, h) + aoff + m * 2048 + k * 1024); } while (0)
#define PG8_LDB(dst, b, h) do { _Pragma("unroll") for (int n = 0; n < 2; ++n) _Pragma("unroll") for (int k = 0; k < 2; ++k) dst[n][k] = *(const LAS bf16x8*)(lds + PG8_SB(b, h) + boff + n * 2048 + k * 1024); } while (0)
#define PG8_MMA(ai, bj, At, Bt) do { __builtin_amdgcn_s_setprio(1); _Pragma("unroll") for (int m = 0; m < 4; ++m) _Pragma("unroll") for (int n = 0; n < 2; ++n) _Pragma("unroll") for (int k = 0; k < 2; ++k) \
        acc[ai][bj][m][n] = __builtin_amdgcn_mfma_f32_16x16x32_bf16(Bt[n][k], At[m][k], acc[ai][bj][m][n], 0, 0, 0); __builtin_amdgcn_s_setprio(0); } while (0)
#define PG8_WAIT_V(n) asm volatile("s_waitcnt vmcnt(" #n ")" ::: "memory")
#define PG8_WAIT_L(n) asm volatile("s_waitcnt lgkmcnt(" #n ")" ::: "memory")
#define PG8_BAR __builtin_amdgcn_s_barrier()
#define PG8_SCHED __builtin_amdgcn_sched_barrier(0)
#define PG8_ACOL(pn) ((size_t)(g.acol_div ? ((pn) / g.acol_div) * 512 : 0))
    Unit cur, nxt; int ui = 0;
    if (!S.next(0, cur)) return;
    f32x4 acc[2][2][4][2];
#pragma unroll
    for (int a = 0; a < 2; ++a)
#pragma unroll
        for (int b = 0; b < 2; ++b)
#pragma unroll
            for (int m = 0; m < 4; ++m)
#pragma unroll
                for (int n = 0; n < 2; ++n) acc[a][b][m][n] = (f32x4){0.f, 0.f, 0.f, 0.f};
    bf16x8 At[4][2], B0[2][2], B1[2][2];
    const char* cA = (const char*)g.A + (size_t)cur.pm * tstepA + PG8_ACOL(cur.pn); const char* cB = (const char*)g.Bt + (size_t)cur.pn * tstepB;
    int ppm = -1, ppar = 1;
#define PG8_PANEL(pm) do { if ((pm) != ppm) { ppm = (pm); ppar ^= 1; if (tid < 256) { const GAS float* sp_ = (const GAS float*)E.rstd + (size_t)(pm) * 256 + tid; float s0_ = 0.f, s1_ = 0.f; \
            _Pragma("unroll") for (int k_ = 0; k_ < 16; k_ += 2) { s0_ += sp_[(size_t)k_ * M]; s1_ += sp_[(size_t)(k_ + 1) * M]; } \
            ((LAS float*)(lds + LDS_STAT))[ppar * 256 + tid] = rsqrtf((s0_ + s1_) * (1.0f / DM) + EPS); } } } while (0)
    if constexpr (Epi::HAS_RS) { if (E.rstd) PG8_PANEL(cur.pm); }
    PG8_STAGE(PG8_SB(0, 0), cB, voffB); PG8_STAGE(PG8_SB(0, 1), cB + hstepB, voffB); PG8_STAGE(PG8_SA(0, 0), cA, voffA); PG8_STAGE(PG8_SA(0, 1), cA + hstepA, voffA);
    if (wr == 1) PG8_BAR;
    PG8_WAIT_V(2); PG8_BAR;
    PG8_STAGE(PG8_SB(1, 0), cB + kstep, voffB); PG8_STAGE(PG8_SA(1, 0), cA + kstep, voffA); PG8_STAGE(PG8_SB(1, 1), cB + hstepB + kstep, voffB);
    PG8_WAIT_V(6); PG8_BAR;
    for (;;) {
        const bool has_next = S.next(ui + 1, nxt);
        const char* nA = has_next ? (const char*)g.A + (size_t)nxt.pm * tstepA + PG8_ACOL(nxt.pn) : cA; const char* nB = has_next ? (const char*)g.Bt + (size_t)nxt.pn * tstepB : cB;
        for (int t = 0; t < nt; t += 2) {
            const bool last = (t == nt - 2);
            const char* a1 = cA + (size_t)(t + 1) * kstep;
            const char* a2 = last ? nA : cA + (size_t)(t + 2) * kstep; const char* b2 = last ? nB : cB + (size_t)(t + 2) * kstep;
            const char* a3 = a2 + kstep; const char* b3 = b2 + kstep;
            PG8_LDB(B0, 0, 0); PG8_LDB(B1, 0, 1); PG8_SCHED; PG8_LDA(At, 0, 0); PG8_STAGE(PG8_SA(1, 1), a1 + hstepA, voffA);
            PG8_WAIT_V(8); PG8_WAIT_L(0); PG8_BAR; PG8_MMA(0, 0, At, B0); PG8_MMA(0, 1, At, B1); PG8_BAR; PG8_SCHED;
            PG8_LDA(At, 0, 1); PG8_STAGE(PG8_SB(0, 0), b2, voffB); PG8_STAGE(PG8_SB(0, 1), b2 + hstepB, voffB); PG8_STAGE(PG8_SA(0, 0), a2, voffA);
            PG8_WAIT_V(8); PG8_WAIT_L(0); PG8_BAR; PG8_MMA(1, 0, At, B0); PG8_MMA(1, 1, At, B1); PG8_BAR; PG8_SCHED;
            PG8_LDB(B0, 1, 0); PG8_LDB(B1, 1, 1); PG8_SCHED; PG8_LDA(At, 1, 0); PG8_STAGE(PG8_SA(0, 1), a2 + hstepA, voffA);
            PG8_WAIT_V(8); PG8_WAIT_L(0); PG8_BAR; PG8_MMA(0, 0, At, B0); PG8_MMA(0, 1, At, B1); PG8_BAR; PG8_SCHED;
            PG8_LDA(At, 1, 1); PG8_STAGE(PG8_SB(1, 0), b3, voffB); PG8_STAGE(PG8_SB(1, 1), b3 + hstepB, voffB); PG8_STAGE(PG8_SA(1, 0), a3, voffA);
            PG8_WAIT_V(8); PG8_WAIT_L(0); PG8_BAR; PG8_MMA(1, 0, At, B0); PG8_MMA(1, 1, At, B1); PG8_BAR; PG8_SCHED;
        }
        if (wr == 0) PG8_BAR;
        E(acc, cur, wr, wc, fr, fq, lds, ppar);
        if (!has_next) break;
#pragma unroll
        for (int a = 0; a < 2; ++a)
#pragma unroll
            for (int b = 0; b < 2; ++b)
#pragma unroll
                for (int m = 0; m < 4; ++m)
#pragma unroll
                    for (int n = 0; n < 2; ++n) acc[a][b][m][n] = (f32x4){0.f, 0.f, 0.f, 0.f};
        cur = nxt; cA = nA; cB = nB; ++ui;
        if (wr == 1) PG8_BAR;
        if constexpr (Epi::HAS_RS) { if (E.rstd) PG8_PANEL(cur.pm); }
    }
    PG8_WAIT_V(0);
    PG8_BAR;
#undef PG8_SA
#undef PG8_SB
#undef PG8_STAGE
#undef PG8_LDA
#undef PG8_LDB
#undef PG8_MMA
#undef PG8_WAIT_V
#undef PG8_WAIT_L
#undef PG8_BAR
#undef PG8_SCHED
#undef PG8_ACOL
#undef PG8_PANEL
}
}

struct WJob { const float* src; const float* gain; int K, N, kind, aux; bf16_t* dst; };
struct Params { const float* in[27]; float* out; unsigned char* ws; int ph_lo, ph_hi; };

__device__ __forceinline__ const float* inp(const Params& p, int k);
__device__ __forceinline__ WJob wjob(const Params& p, unsigned char* ws, int j) {
    WJob w; w.kind = 0; w.aux = 0; w.gain = nullptr;
    const float* ng = inp(p, 3);
    if (j < 16) { const int f = j >> 1;
        if ((j & 1) == 0) { w.src = inp(p, 1) + (size_t)f * DM * 2 * FF; w.K = DM; w.N = 2 * FF; w.kind = 1; w.gain = ng + (size_t)((f >> 1) * 3 + ((f & 1) ? 2 : 0)) * DM; w.dst = (bf16_t*)(ws + WS_W + f * FFN_STRIDE); }
        else { w.src = inp(p, 2) + (size_t)f * FF * DM; w.K = FF; w.N = DM; w.dst = (bf16_t*)(ws + WS_W + f * FFN_STRIDE + WD_OFF); }
        return w; }
    switch (j) {
        case 16: w.src = inp(p, 5); w.gain = ng + (size_t)(0 * 3 + 1) * DM; w.K = DM; w.N = 4096; w.dst = (bf16_t*)(ws + WS_HG_IN); break;
        case 17: w.src = inp(p, 8); w.K = DM; w.N = DM; w.dst = (bf16_t*)(ws + WS_HG_OUT); break;
        case 18: w.src = inp(p, 9); w.gain = ng + (size_t)(1 * 3 + 1) * DM; w.K = DM; w.N = 3072; w.dst = (bf16_t*)(ws + WS_GL_IN); break;
        case 19: w.src = inp(p, 10); w.gain = ng + (size_t)(1 * 3 + 1) * DM; w.K = DM; w.N = 512; w.kind = 2; w.dst = (bf16_t*)(ws + WS_GL_IN) + (size_t)3072 * DM; break;
        case 20: w.src = inp(p, 14); w.K = DM; w.N = DM; w.dst = (bf16_t*)(ws + WS_GL_OUT); break;
        case 21: w.src = inp(p, 15); w.gain = ng + (size_t)(2 * 3 + 1) * DM; w.K = DM; w.N = 3072; w.dst = (bf16_t*)(ws + WS_AT_IN); break;
        case 22: w.src = inp(p, 17); w.K = DM; w.N = DM; w.dst = (bf16_t*)(ws + WS_AT_OUT); break;
        case 23: w.src = inp(p, 18); w.gain = ng + (size_t)(3 * 3 + 1) * DM; w.K = DM; w.N = 2048; w.dst = (bf16_t*)(ws + WS_LR_IN); break;
        case 32: w.src = inp(p, 26); w.K = DM; w.N = DM; w.dst = (bf16_t*)(ws + WS_LR_OUT); break;
        default: { const int q = j - 24, gsel = q >> 2, head = q & 3; w.src = inp(p, gsel ? 23 : 21) + (size_t)head * 65536; w.K = 256; w.N = 256; w.kind = 3; w.aux = q; w.dst = (bf16_t*)(ws + WS_LR_GATE); } break;
    }
    return w;
}
constexpr int NWJOBS = 33;

__device__ __forceinline__ void weights_phase(const int tid, const int bid, const int G, const Params& p, unsigned char* ws, unsigned char* lds) {
    const int lane = tid & 63, wid = tid >> 6;
    float* scr = (float*)(lds + wid * 8448);
    const int gw = bid * 8 + wid, NGW = G * 8;
    int base = 0;
    for (int j = 0; j < NWJOBS; ++j) {
        const WJob w = wjob(p, ws, j);
        const int nblk = w.N / 32, nitems = (w.K / 64) * nblk;
        int first = (gw - base % NGW + NGW) % NGW;
        for (int it = first; it < nitems; it += NGW) {
            const int kb = it / nblk, nb = it % nblk, k0 = 64 * kb, n0 = 32 * nb;
            if (w.kind == 2) {
                const float* wd = w.src; const float* wu = inp(p, 11);
#pragma unroll 4
                for (int i = 0; i < 32; ++i) { const int kk = 2 * i + (lane >> 5); float s = 0.f;
#pragma unroll
                    for (int r = 0; r < 16; ++r) s += wd[(size_t)(k0 + kk) * 16 + r] * wu[r * 512 + n0 + (lane & 31)];
                    scr[kk * 33 + (lane & 31)] = s; }
            } else {
#pragma unroll 8
                for (int i = 0; i < 32; ++i) { const int kk = 2 * i + (lane >> 5); scr[kk * 33 + (lane & 31)] = ((const GAS float*)w.src)[(size_t)(k0 + kk) * w.N + n0 + (lane & 31)]; }
            }
            int drow0 = n0;
            if (w.kind == 1) { const int jj = n0 < FF ? n0 : n0 - FF; drow0 = 256 * (jj >> 7) + (jj & 127) + (n0 < FF ? 0 : 128); }
            else if (w.kind == 3) { const int gsel = w.aux >> 2, head = w.aux & 3, c = 256 * head + n0; drow0 = 256 * (c >> 7) + 128 * gsel + (c & 127); }
            __builtin_amdgcn_wave_barrier();
            asm volatile("s_waitcnt lgkmcnt(0)" ::: "memory");
            const int c = lane & 7;
            f32x4 g0 = (f32x4){1.f, 1.f, 1.f, 1.f}, g1 = g0;
            if (w.gain) { g0 = *(const f32x4*)(w.gain + k0 + 8 * c); g1 = *(const f32x4*)(w.gain + k0 + 8 * c + 4); }
#pragma unroll
            for (int q = 0; q < 4; ++q) { const int n = (lane >> 3) + 8 * q; const float* s = scr + (8 * c) * 33 + n;
                u32x4 o; o.x = pkbf(s[0 * 33] * g0[0], s[1 * 33] * g0[1]); o.y = pkbf(s[2 * 33] * g0[2], s[3 * 33] * g0[3]); o.z = pkbf(s[4 * 33] * g1[0], s[5 * 33] * g1[1]); o.w = pkbf(s[6 * 33] * g1[2], s[7 * 33] * g1[3]);
                *(GAS u32x4*)((GAS bf16_t*)w.dst + (size_t)(drow0 + n) * w.K + k0 + 8 * c) = o; }
            asm volatile("s_waitcnt lgkmcnt(0)" ::: "memory");
            __builtin_amdgcn_wave_barrier();
        }
        base += nitems;
    }
}

__device__ __forceinline__ void first_phase(const int tid, const int bid, const int G, const float* src, bf16_t* xr, float* rstd) {
    const int lane = tid & 63, wid = tid >> 6;
    const int gw = bid * 8 + wid, NGW = G * 8;
    for (int row = gw; row < M; row += NGW) {
        const GAS f32x4* xp = (const GAS f32x4*)(src + (size_t)row * DM) + lane;
        f32x4 v[4]; float s = 0.f;
#pragma unroll
        for (int j = 0; j < 4; ++j) { v[j] = xp[64 * j]; s += (v[j].x * v[j].x + v[j].y * v[j].y) + (v[j].z * v[j].z + v[j].w * v[j].w); }
        s = wave_sum(s, lane);
        if (lane < 16) ((GAS float*)rstd)[(size_t)lane * M + row] = lane == 0 ? s : 0.f;
#pragma unroll
        for (int j = 0; j < 4; ++j) { u32x2 w; w.x = pkbf(v[j].x, v[j].y); w.y = pkbf(v[j].z, v[j].w); ((GAS u32x2*)(xr + (size_t)row * DM))[lane + 64 * j] = w; }
    }
}
__device__ __forceinline__ void rstd_phase(const int tid, const int bid, const int G, const float* ssp, float* rstd) {
    for (int row = bid * 512 + tid; row < M; row += G * 512) { float s0 = 0.f, s1 = 0.f;
#pragma unroll
        for (int k = 0; k < 16; k += 2) { s0 += ((const GAS float*)ssp)[(size_t)k * M + row]; s1 += ((const GAS float*)ssp)[(size_t)(k + 1) * M + row]; }
        ((GAS float*)rstd)[row] = rsqrtf((s0 + s1) * (1.0f / DM) + EPS); }
}
__device__ __forceinline__ void final_phase(const int tid, const int bid, const int G, const bf16_t* xr, const float* ssp, float* fdst, const float* gain) {
    const int lane = tid & 63, wid = tid >> 6;
    const int gw = bid * 8 + wid, NGW = G * 8;
    f32x4 gv[2][2];
#pragma unroll
    for (int j = 0; j < 2; ++j) { gv[j][0] = *(const f32x4*)(gain + 8 * lane + 512 * j); gv[j][1] = *(const f32x4*)(gain + 8 * lane + 512 * j + 4); }
    for (int row = gw; row < M; row += NGW) {
        const GAS bf16_t* xp = (const GAS bf16_t*)xr + (size_t)row * DM + 8 * lane;
        float sp = lane < 16 ? ((const GAS float*)ssp)[(size_t)lane * M + row] : 0.f;
        sp += shx(sp, 1, lane); sp += shx(sp, 2, lane); sp += shx(sp, 4, lane); sp += shx(sp, 8, lane);
        const float r = rsqrtf(__int_as_float(__builtin_amdgcn_readfirstlane(__float_as_int(sp))) * (1.0f / DM) + EPS);
#pragma unroll
        for (int j = 0; j < 2; ++j) { const u32x4 q = *(const GAS u32x4*)(xp + 512 * j);
            const float v[8] = {bflo(q.x), bfhi(q.x), bflo(q.y), bfhi(q.y), bflo(q.z), bfhi(q.z), bflo(q.w), bfhi(q.w)};
            GAS float* op = (GAS float*)fdst + (size_t)row * DM + 8 * lane + 512 * j;
            *(GAS f32x4*)op = (f32x4){v[0] * r * gv[j][0][0], v[1] * r * gv[j][0][1], v[2] * r * gv[j][0][2], v[3] * r * gv[j][0][3]};
            *(GAS f32x4*)(op + 4) = (f32x4){v[4] * r * gv[j][1][0], v[5] * r * gv[j][1][1], v[6] * r * gv[j][1][2], v[7] * r * gv[j][1][3]}; }
    }
}

template <int MODE>
__device__ __forceinline__ void la_prep(const int tid, const int bid, const int G, unsigned char* lds, bf16_t* P, const float* lbl, int layer, const float* gbias, bf16_t* Aout, float* dlast) {
    constexpr int H = MODE == 0 ? 8 : 4, ldp = MODE == 0 ? 4096 : 3584;
    const int lane = tid & 63, wid = tid >> 6, cp = lane, seg = wid, l15 = lane & 15, kq = lane >> 4;
    LAS bf16_t* sQ = (LAS bf16_t*)(LAS unsigned char*)lds; LAS bf16_t* sK = sQ + 64 * 136; LAS float* sTot = (LAS float*)(sK + 64 * 136);
    GAS bf16_t* Pg = (GAS bf16_t*)P; GAS bf16_t* Ag = (GAS bf16_t*)Aout; GAS float* Dg = (GAS float*)dlast; const GAS float* lblg = (const GAS float*)lbl; const GAS float* gbg = (const GAS float*)gbias;
    const float scale = 0.08838834764831845f;
    constexpr int nunits = NB * H * NCHUNK;
    unsigned nq[8], nk[8], nl[8];
#define LAP_FETCH(uu) do { const int c_ = (uu) & 127, h_ = ((uu) >> 7) % H, b_ = ((uu) >> 7) / H; const GAS bf16_t* rp_ = Pg + ((size_t)b_ * SEQ + (size_t)c_ * 64 + seg * 8) * ldp + 2 * cp + h_ * 128; \
        _Pragma("unroll") for (int i_ = 0; i_ < 8; ++i_) { nq[i_] = *(const GAS unsigned*)(rp_ + (size_t)i_ * ldp); nk[i_] = *(const GAS unsigned*)(rp_ + (size_t)i_ * ldp + (MODE == 0 ? 1024 : 512)); \
            if (MODE == 1) nl[i_] = *(const GAS unsigned*)(rp_ + (size_t)i_ * ldp + 3072); else nl[i_] = 0u; } } while (0)
    if (bid < nunits) LAP_FETCH(bid);
    for (int u = bid; u < nunits; u += G) {
        const int c = u & 127, h = (u >> 7) % H, b = (u >> 7) / H;
        const size_t row0 = (size_t)b * SEQ + (size_t)c * 64;
        const int qcol = h * 128, kcol = (MODE == 0 ? 1024 : 512) + h * 128;
        unsigned cq[8], ck[8], cl2[8];
#pragma unroll
        for (int i = 0; i < 8; ++i) { cq[i] = nq[i]; ck[i] = nk[i]; cl2[i] = nl[i]; }
        if (u + G < nunits) LAP_FETCH(u + G);
        const int ch0 = h * 128 + 2 * cp;
        float cc0 = 0.f, cc1 = 0.f;
        if (MODE == 0) {
#pragma unroll
            for (int e = 0; e < 2; ++e) { float v[5], mx = -1e30f;
#pragma unroll
                for (int q = 0; q < 5; ++q) { v[q] = lblg[q * DM + ch0 + e]; mx = fmaxf(mx, v[q]); }
                float den = 0.f, num = 0.f;
#pragma unroll
                for (int q = 0; q < 5; ++q) { const float ex = __expf(v[q] - mx); den += ex; if (q <= layer) num += ex; }
                const float lb = num / den; if (e == 0) cc0 = lb; else cc1 = lb; }
        } else { cc0 = gbg[ch0]; cc1 = gbg[ch0 + 1]; }
        float qv[8][2], kv[8][2], cl[8][2];
        float run0 = 0.f, run1 = 0.f;
#pragma unroll
        for (int i = 0; i < 8; ++i) { const int t = seg * 8 + i;
            const unsigned q2 = cq[i], k2 = ck[i];
            float g0, g1;
            if (MODE == 0) {
                qv[i][0] = silu(bflo(q2)); qv[i][1] = silu(bfhi(q2));
                const float f0 = cc0 + (1.0f - cc0) * sigm(bflo(k2)), f1 = cc1 + (1.0f - cc1) * sigm(bfhi(k2));
                kv[i][0] = 1.0f - f0; kv[i][1] = 1.0f - f1; g0 = __logf(f0); g1 = __logf(f1);
            } else {
                const unsigned l2 = cl2[i];
                qv[i][0] = bflo(q2); qv[i][1] = bfhi(q2); kv[i][0] = bflo(k2); kv[i][1] = bfhi(k2);
                const float z0 = bflo(l2) + cc0, z1 = bfhi(l2) + cc1;
                g0 = (fminf(z0, 0.f) - __logf(1.0f + __expf(-fabsf(z0)))) * 0.0625f; g1 = (fminf(z1, 0.f) - __logf(1.0f + __expf(-fabsf(z1)))) * 0.0625f;
            }
            run0 += g0; run1 += g1; cl[i][0] = run0; cl[i][1] = run1; }
        sTot[seg * 128 + 2 * cp] = run0; sTot[seg * 128 + 2 * cp + 1] = run1;
        __syncthreads();
        float pre0 = 0.f, pre1 = 0.f, ref0 = 0.f, ref1 = 0.f, last0 = 0.f, last1 = 0.f;
#pragma unroll
        for (int s = 0; s < 8; ++s) { const float a0 = sTot[s * 128 + 2 * cp], a1 = sTot[s * 128 + 2 * cp + 1];
            if (s < seg) { pre0 += a0; pre1 += a1; } if (s < 4) { ref0 += a0; ref1 += a1; } last0 += a0; last1 += a1; }
        unsigned kh0[4], kh1[4];
#pragma unroll
        for (int i = 0; i < 8; ++i) { const int t = seg * 8 + i;
            const float c0 = pre0 + cl[i][0], c1 = pre1 + cl[i][1];
            const float qs0 = qv[i][0] * scale, qs1 = qv[i][1] * scale;
            const float d0 = fminf(fmaxf(c0 - ref0, -80.f), 80.f), d1 = fminf(fmaxf(c1 - ref1, -80.f), 80.f);
            *(LAS unsigned*)(sQ + t * 136 + 2 * cp) = pkbf(qs0 * __expf(d0), qs1 * __expf(d1));
            *(LAS unsigned*)(sK + t * 136 + 2 * cp) = pkbf(kv[i][0] * __expf(-d0), kv[i][1] * __expf(-d1));
            *(GAS unsigned*)(Pg + (row0 + t) * ldp + qcol + 2 * cp) = pkbf(qs0 * __expf(c0), qs1 * __expf(c1));
            cl[i][0] = kv[i][0] * __expf(last0 - c0); cl[i][1] = kv[i][1] * __expf(last1 - c1); }
#pragma unroll
        for (int i = 0; i < 4; ++i) { kh0[i] = pkbf(cl[2 * i][0], cl[2 * i + 1][0]); kh1[i] = pkbf(cl[2 * i][1], cl[2 * i + 1][1]); }
        { GAS bf16_t* kp = Pg + (row0 + cp) * ldp + kcol + 8 * seg;
          *(GAS u32x4*)kp = (u32x4){kh0[0], kh0[1], kh0[2], kh0[3]}; *(GAS u32x4*)(kp + 64) = (u32x4){kh1[0], kh1[1], kh1[2], kh1[3]}; }
        if (seg == 0) { Dg[(size_t)u * 128 + 2 * cp] = __expf(last0); Dg[(size_t)u * 128 + 2 * cp + 1] = __expf(last1); }
        __syncthreads();
        { const int tt = wid >> 1;
#pragma unroll
          for (int sti = 0; sti < 2; ++sti) { const int st = 2 * (wid & 1) + sti;
            f32x4 acc = (f32x4){0.f, 0.f, 0.f, 0.f};
            if (st <= tt) {
#pragma unroll
                for (int ks = 0; ks < 4; ++ks) {
                    const bf16x8 a = *(const LAS bf16x8*)(sK + (st * 16 + l15) * 136 + ks * 32 + kq * 8);
                    const bf16x8 bq = *(const LAS bf16x8*)(sQ + (tt * 16 + l15) * 136 + ks * 32 + kq * 8);
                    acc = MFMA16(a, bq, acc); }
            }
            const int t = tt * 16 + l15, s0 = st * 16 + kq * 4;
            float v[4];
#pragma unroll
            for (int j = 0; j < 4; ++j) v[j] = (s0 + j <= t) ? acc[j] : 0.f;
            u32x2 w; w.x = pkbf(v[0], v[1]); w.y = pkbf(v[2], v[3]);
            *(GAS u32x2*)(Ag + (size_t)u * 4096 + t * 64 + s0) = w; } }
        __syncthreads();
    }
}

template <int MODE>
__device__ __forceinline__ void la_scan(const int tid, const int bid, const int G, unsigned char* lds, const bf16_t* P, const bf16_t* Ain, const float* dlast, bf16_t* O) {
    constexpr int H = MODE == 0 ? 8 : 4, ldp = MODE == 0 ? 4096 : 3584, DV = MODE == 0 ? 128 : 256, NVS = DV / 32;
    constexpr int BUF = 50176;
    const int lane = tid & 63, w = tid >> 6, l15 = lane & 15, kq = lane >> 4;
    const GAS bf16_t* Pg = (const GAS bf16_t*)P; const GAS bf16_t* Ag = (const GAS bf16_t*)Ain; const GAS float* Dg = (const GAS float*)dlast; GAS bf16_t* Og = (GAS bf16_t*)O;
    LAS unsigned char* l3 = (LAS unsigned char*)lds;
    LAS bf16_t* sS = (LAS bf16_t*)(l3 + 2 * BUF);
    constexpr int ntasks = NB * H * NVS;
    const int vcu = (G % 8 == 0) ? (bid % 8) * (G / 8) + bid / 8 : bid;
    for (int task = vcu; task < ntasks; task += G) {
        const int vs = task % NVS, h = (task / NVS) % H, b = task / (NVS * H);
        const int qcol = h * 128, kcol = (MODE == 0 ? 1024 : 512) + h * 128, vcol = (MODE == 0 ? 2048 : 1024) + h * DV + vs * 32, ocol = h * DV + vs * 32;
        const size_t u0 = (size_t)(b * H + h) * NCHUNK;
        const size_t rowb = (size_t)b * SEQ;
        __syncthreads();
        for (int i = tid; i < 32 * 136 / 2; i += 512) ((LAS unsigned*)sS)[i] = 0u;
        u32x4 rA, rQ[2], rK[2]; u32x2 rV; float rD = 0.f;
#define LA_LOAD(c) do { const size_t r0_ = rowb + (size_t)(c) * 64; \
            rA = *(const GAS u32x4*)(Ag + (u0 + (c)) * 4096 + (tid >> 3) * 64 + (tid & 7) * 8); \
            _Pragma("unroll") for (int i_ = 0; i_ < 2; ++i_) { const int idx_ = tid + 512 * i_, r_ = idx_ >> 4, c8_ = (idx_ & 15) * 8; \
                rQ[i_] = *(const GAS u32x4*)(Pg + (r0_ + r_) * ldp + qcol + c8_); rK[i_] = *(const GAS u32x4*)(Pg + (r0_ + r_) * ldp + kcol + c8_); } \
            rV = *(const GAS u32x2*)(Pg + (r0_ + (tid >> 3)) * ldp + vcol + (tid & 7) * 4); \
            if (tid < 128) rD = Dg[(u0 + (c)) * 128 + tid]; } while (0)
#define LA_WRITE(buf) do { LAS unsigned char* bb_ = l3 + (buf) * BUF; LAS bf16_t* sA_ = (LAS bf16_t*)bb_; LAS bf16_t* sQ_ = (LAS bf16_t*)(bb_ + 9216); LAS bf16_t* sK_ = (LAS bf16_t*)(bb_ + 26624); LAS bf16_t* sV_ = (LAS bf16_t*)(bb_ + 45056); LAS float* sD_ = (LAS float*)(bb_ + 49664); \
            *(LAS u32x4*)(sA_ + (tid >> 3) * 72 + (tid & 7) * 8) = rA; \
            _Pragma("unroll") for (int i_ = 0; i_ < 2; ++i_) { const int idx_ = tid + 512 * i_, r_ = idx_ >> 4, c8_ = (idx_ & 15) * 8; \
                *(LAS u32x4*)(sQ_ + r_ * 136 + c8_) = rQ[i_]; *(LAS u32x4*)(sK_ + (2 * r_ + (c8_ >> 6)) * 72 + (c8_ & 63)) = rK[i_]; } \
            { const int s_ = tid >> 3, v4_ = (tid & 7) * 4; sV_[(v4_ + 0) * 72 + s_] = (bf16_t)(rV.x & 0xffffu); sV_[(v4_ + 1) * 72 + s_] = (bf16_t)(rV.x >> 16); \
              sV_[(v4_ + 2) * 72 + s_] = (bf16_t)(rV.y & 0xffffu); sV_[(v4_ + 3) * 72 + s_] = (bf16_t)(rV.y >> 16); } \
            if (tid < 128) sD_[tid] = rD; } while (0)
        LA_LOAD(0);
        LA_WRITE(0);
        __syncthreads();
        f32x4 st[2]; st[0] = (f32x4){0.f, 0.f, 0.f, 0.f}; st[1] = (f32x4){0.f, 0.f, 0.f, 0.f};
        const int tt = w >> 1, vt = w & 1;
        for (int c = 0; c < NCHUNK; ++c) {
            const int cur = c & 1;
            if (c + 1 < NCHUNK) LA_LOAD(c + 1);
            const LAS unsigned char* bb = l3 + cur * BUF;
            const LAS bf16_t* sA = (const LAS bf16_t*)bb; const LAS bf16_t* sQ = (const LAS bf16_t*)(bb + 9216); const LAS bf16_t* sK = (const LAS bf16_t*)(bb + 26624); const LAS bf16_t* sV = (const LAS bf16_t*)(bb + 45056); const LAS float* sD = (const LAS float*)(bb + 49664);
            f32x4 o = (f32x4){0.f, 0.f, 0.f, 0.f};
#pragma unroll
            for (int ks = 0; ks < 2; ++ks) {
                const bf16x8 a = *(const LAS bf16x8*)(sV + (vt * 16 + l15) * 72 + ks * 32 + kq * 8);
                const bf16x8 bq = *(const LAS bf16x8*)(sA + (tt * 16 + l15) * 72 + ks * 32 + kq * 8);
                o = MFMA16(a, bq, o); }
#pragma unroll
            for (int ks = 0; ks < 4; ++ks) {
                const bf16x8 a = *(const LAS bf16x8*)(sS + (vt * 16 + l15) * 136 + ks * 32 + kq * 8);
                const bf16x8 bq = *(const LAS bf16x8*)(sQ + (tt * 16 + l15) * 136 + ks * 32 + kq * 8);
                o = MFMA16(a, bq, o); }
            { u32x2 wv; wv.x = pkbf(o[0], o[1]); wv.y = pkbf(o[2], o[3]);
              *(GAS u32x2*)(Og + (rowb + (size_t)c * 64 + tt * 16 + l15) * DM + ocol + vt * 16 + kq * 4) = wv; }
            const float dk = sD[w * 16 + l15];
#pragma unroll
            for (int v2 = 0; v2 < 2; ++v2) {
                st[v2] = st[v2] * dk;
#pragma unroll
                for (int ks = 0; ks < 2; ++ks) {
                    const bf16x8 a = *(const LAS bf16x8*)(sV + (v2 * 16 + l15) * 72 + ks * 32 + kq * 8);
                    const bf16x8 bk = *(const LAS bf16x8*)(sK + (w * 16 + l15) * 72 + ks * 32 + kq * 8);
                    st[v2] = MFMA16(a, bk, st[v2]); } }
            __syncthreads();
#pragma unroll
            for (int v2 = 0; v2 < 2; ++v2) {
                const unsigned p01 = pkbf(st[v2][0], st[v2][1]), p23 = pkbf(st[v2][2], st[v2][3]);
                LAS bf16_t* sp = sS + (v2 * 16 + kq * 4) * 136 + w * 16 + l15;
                sp[0] = (bf16_t)(p01 & 0xffffu); sp[136] = (bf16_t)(p01 >> 16); sp[272] = (bf16_t)(p23 & 0xffffu); sp[408] = (bf16_t)(p23 >> 16); }
            if (c + 1 < NCHUNK) LA_WRITE(cur ^ 1);
            __syncthreads();
        }
#undef LA_LOAD
#undef LA_WRITE
    }
}

template <int MODE>
__device__ __forceinline__ void la_post(const int tid, const int bid, const int G, bf16_t* O, const bf16_t* P, const float* gain) {
    constexpr int ldp = MODE == 0 ? 4096 : 3584, DV = MODE == 0 ? 128 : 256, GRP = DV / 16, gcol = MODE == 0 ? 3072 : 2048;
    const int lane = tid & 63, wid = tid >> 6;
    const int gw = bid * 8 + wid, NGW = G * 8;
    float gn[16];
#pragma unroll
    for (int e = 0; e < 16; ++e) gn[e] = gain[(lane % GRP) * 16 + e];
    for (int row = gw; row < M; row += NGW) {
        GAS bf16_t* op = (GAS bf16_t*)O + (size_t)row * DM + lane * 16; const GAS bf16_t* gp = (const GAS bf16_t*)P + (size_t)row * ldp + gcol + lane * 16;
        const u32x4 o0 = *(const GAS u32x4*)op, o1 = *(const GAS u32x4*)(op + 8), g0 = *(const GAS u32x4*)gp, g1 = *(const GAS u32x4*)(gp + 8);
        const float ov[16] = {bflo(o0.x), bfhi(o0.x), bflo(o0.y), bfhi(o0.y), bflo(o0.z), bfhi(o0.z), bflo(o0.w), bfhi(o0.w),
                              bflo(o1.x), bfhi(o1.x), bflo(o1.y), bfhi(o1.y), bflo(o1.z), bfhi(o1.z), bflo(o1.w), bfhi(o1.w)};
        const float gv[16] = {bflo(g0.x), bfhi(g0.x), bflo(g0.y), bfhi(g0.y), bflo(g0.z), bfhi(g0.z), bflo(g0.w), bfhi(g0.w),
                              bflo(g1.x), bfhi(g1.x), bflo(g1.y), bfhi(g1.y), bflo(g1.z), bfhi(g1.z), bflo(g1.w), bfhi(g1.w)};
        float ss = 0.f;
#pragma unroll
        for (int e = 0; e < 16; ++e) ss += ov[e] * ov[e];
#pragma unroll
        for (int off = 1; off < GRP; off <<= 1) ss += shx(ss, off, lane);
        const float r = rsqrtf(ss * (1.0f / DV) + EPS);
        float y[16];
#pragma unroll
        for (int e = 0; e < 16; ++e) y[e] = ov[e] * r * gn[e] * silu(gv[e]);
        u32x4 w0, w1; w0.x = pkbf(y[0], y[1]); w0.y = pkbf(y[2], y[3]); w0.z = pkbf(y[4], y[5]); w0.w = pkbf(y[6], y[7]);
        w1.x = pkbf(y[8], y[9]); w1.y = pkbf(y[10], y[11]); w1.z = pkbf(y[12], y[13]); w1.w = pkbf(y[14], y[15]);
        *(GAS u32x4*)op = w0; *(GAS u32x4*)(op + 8) = w1;
    }
}

__device__ __forceinline__ void attn_tile(const LAS bf16_t* kb, const LAS bf16_t* vb, const LAS float* sB, const bf16x8 (&qf)[2][2], f32x4 (&oacc)[4][2], float (&mrow)[2], float (&lrow)[2],
                                          const int kc, const int qpos0, const int lane, const int l15, const int kq) {
    f32x4 s[4][2];
#pragma unroll
    for (int kt = 0; kt < 4; ++kt) {
        const bf16x8 ka0 = *(const LAS bf16x8*)(kb + (kt * 16 + l15) * 72 + kq * 8), ka1 = *(const LAS bf16x8*)(kb + (kt * 16 + l15) * 72 + 32 + kq * 8);
#pragma unroll
        for (int qt = 0; qt < 2; ++qt) { f32x4 z = (f32x4){0.f, 0.f, 0.f, 0.f}; z = MFMA16(ka0, qf[qt][0], z); s[kt][qt] = MFMA16(ka1, qf[qt][1], z); } }
#pragma unroll
    for (int qt = 0; qt < 2; ++qt) {
        const int qp = qpos0 + qt * 16 + l15;
        float mx = -1e30f;
#pragma unroll
        for (int kt = 0; kt < 4; ++kt)
#pragma unroll
            for (int j = 0; j < 4; ++j) { int d = qp - (kc * 64 + kt * 16 + kq * 4 + j); d = d < -63 ? -63 : (d > 128 ? 128 : d);
                const float val = s[kt][qt][j] * 0.125f + sB[d + 63]; s[kt][qt][j] = val; mx = fmaxf(mx, val); }
        mx = fmaxf(mx, shx(mx, 16, lane)); mx = fmaxf(mx, shx(mx, 32, lane));
        const float mnew = fmaxf(mrow[qt], mx), alpha = __expf(mrow[qt] - mnew); mrow[qt] = mnew;
        float ps = 0.f;
#pragma unroll
        for (int kt = 0; kt < 4; ++kt)
#pragma unroll
            for (int j = 0; j < 4; ++j) { const float pv = __expf(s[kt][qt][j] - mnew); s[kt][qt][j] = pv; ps += pv; }
        lrow[qt] = lrow[qt] * alpha + ps;
#pragma unroll
        for (int dt = 0; dt < 4; ++dt) oacc[dt][qt] = oacc[dt][qt] * alpha;
    }
#pragma unroll
    for (int kk = 0; kk < 2; ++kk) {
        bf16x8 pb[2];
#pragma unroll
        for (int qt = 0; qt < 2; ++qt) { const f32x4 a = s[2 * kk][qt], c2 = s[2 * kk + 1][qt];
            const u32x4 pw = (u32x4){pkbf(a[0], a[1]), pkbf(a[2], a[3]), pkbf(c2[0], c2[1]), pkbf(c2[2], c2[3])}; pb[qt] = __builtin_bit_cast(bf16x8, pw); }
#pragma unroll
        for (int dt = 0; dt < 4; ++dt) {
            const LAS bf16_t* vp = vb + (dt * 16 + l15) * 72 + kk * 32 + kq * 4;
            const u32x2 lo = *(const LAS u32x2*)vp, hi = *(const LAS u32x2*)(vp + 16);
            const bf16x8 va = __builtin_bit_cast(bf16x8, ((u32x4){lo.x, lo.y, hi.x, hi.y}));
            oacc[dt][0] = MFMA16(va, pb[0], oacc[dt][0]); oacc[dt][1] = MFMA16(va, pb[1], oacc[dt][1]); }
    }
}
__device__ __forceinline__ void attn_phase(const int tid, const int bid, const int G, unsigned char* lds, const bf16_t* P, const float* relb, bf16_t* O) {
    const int lane = tid & 63, w = tid >> 6, l15 = lane & 15, kq = lane >> 4;
    LAS bf16_t* sK = (LAS bf16_t*)(LAS unsigned char*)lds; LAS bf16_t* sV = sK + 2 * 64 * 72; LAS float* sB = (LAS float*)(sV + 2 * 64 * 72);
    constexpr int nunits = NB * 16 * 32, ldp = 3072;
    const GAS bf16_t* Pg = (const GAS bf16_t*)P; const GAS float* relg = (const GAS float*)relb; GAS bf16_t* Og = (GAS bf16_t*)O;
    const int skey = tid >> 3, sd8 = (tid & 7) * 8;
    const int vcu = (G % 8 == 0) ? (bid % 8) * (G / 8) + bid / 8 : bid;
    const int upb = (nunits + G - 1) / G;
    for (int u = vcu * upb; u < nunits && u < (vcu + 1) * upb; ++u) {
        const int qg = u & 31, h = (u >> 5) & 15, b = u >> 9;
        const int cw = qg * 4 + (w >> 1);
        const size_t seq0 = (size_t)b * SEQ;
        const int qpos0 = qg * 256 + w * 32;
        __syncthreads();
        if (tid < 192) sB[tid] = relg[h * 192 + tid];
        bf16x8 qf[2][2];
#pragma unroll
        for (int qt = 0; qt < 2; ++qt)
#pragma unroll
            for (int ks = 0; ks < 2; ++ks) qf[qt][ks] = *(const GAS bf16x8*)(Pg + (seq0 + qpos0 + qt * 16 + l15) * ldp + h * 64 + ks * 32 + kq * 8);
        f32x4 oacc[4][2];
#pragma unroll
        for (int dt = 0; dt < 4; ++dt) { oacc[dt][0] = (f32x4){0.f, 0.f, 0.f, 0.f}; oacc[dt][1] = (f32x4){0.f, 0.f, 0.f, 0.f}; }
        float mrow[2] = {-1e30f, -1e30f}, lrow[2] = {0.f, 0.f};
        const int kc0 = qg * 4 - 8 < 0 ? 0 : qg * 4 - 8, kc1 = qg * 4 + 3;
        u32x4 kA, vA, kB, vB;
#define AT_LOAD(KR, VR, kc) do { const GAS bf16_t* kp_ = Pg + (seq0 + (size_t)(kc) * 64 + skey) * ldp + 1024 + h * 64 + sd8; KR = *(const GAS u32x4*)kp_; VR = *(const GAS u32x4*)(kp_ + 1024); } while (0)
#define AT_WRITE(KR, VR, buf) do { LAS bf16_t* kb_ = sK + (buf) * 64 * 72; LAS bf16_t* vb_ = sV + (buf) * 64 * 72; *(LAS u32x4*)(kb_ + skey * 72 + sd8) = KR; \
            vb_[(sd8 + 0) * 72 + skey] = (bf16_t)(VR.x & 0xffffu); vb_[(sd8 + 1) * 72 + skey] = (bf16_t)(VR.x >> 16); vb_[(sd8 + 2) * 72 + skey] = (bf16_t)(VR.y & 0xffffu); vb_[(sd8 + 3) * 72 + skey] = (bf16_t)(VR.y >> 16); \
            vb_[(sd8 + 4) * 72 + skey] = (bf16_t)(VR.z & 0xffffu); vb_[(sd8 + 5) * 72 + skey] = (bf16_t)(VR.z >> 16); vb_[(sd8 + 6) * 72 + skey] = (bf16_t)(VR.w & 0xffffu); vb_[(sd8 + 7) * 72 + skey] = (bf16_t)(VR.w >> 16); } while (0)
#define AT_ITER(kc, KL, VL, KW, VW) do { const int cur_ = ((kc) - kc0) & 1; \
            if ((kc) + 2 <= kc1) AT_LOAD(KL, VL, (kc) + 2); \
            if ((kc) >= cw - 8 && (kc) <= cw) attn_tile(sK + cur_ * 64 * 72, sV + cur_ * 64 * 72, sB, qf, oacc, mrow, lrow, (kc), qpos0, lane, l15, kq); \
            if ((kc) + 1 <= kc1) AT_WRITE(KW, VW, cur_ ^ 1); \
            __syncthreads(); } while (0)
        AT_LOAD(kA, vA, kc0);
        AT_WRITE(kA, vA, 0);
        if (kc0 + 1 <= kc1) AT_LOAD(kA, vA, kc0 + 1);
        __syncthreads();
        for (int kc = kc0; kc <= kc1; kc += 2) {
            AT_ITER(kc, kB, vB, kA, vA);
            if (kc + 1 <= kc1) AT_ITER(kc + 1, kA, vA, kB, vB);
        }
#undef AT_LOAD
#undef AT_WRITE
#undef AT_ITER
#pragma unroll
        for (int qt = 0; qt < 2; ++qt) { float lt = lrow[qt]; lt += shx(lt, 16, lane); lt += shx(lt, 32, lane); const float inv = 1.0f / lt;
#pragma unroll
            for (int dt = 0; dt < 4; ++dt) { const f32x4 ov = oacc[dt][qt] * inv; u32x2 wv; wv.x = pkbf(ov[0], ov[1]); wv.y = pkbf(ov[2], ov[3]);
                *(GAS u32x2*)(Og + (seq0 + qpos0 + qt * 16 + l15) * DM + h * 64 + dt * 16 + kq * 4) = wv; } }
    }
}

__device__ __forceinline__ void conv_phase(const int tid, const int bid, const int G, const bf16_t* P, const float* cw, const float* cb, bf16_t* XC) {
    const int c8 = (tid & 127) * 8, tq = tid >> 7;
    float wgt[4][8], bias[8];
#pragma unroll
    for (int e = 0; e < 8; ++e) { bias[e] = cb[c8 + e];
#pragma unroll
        for (int j = 0; j < 4; ++j) wgt[j][e] = cw[j * DM + c8 + e]; }
    for (int tile = bid; tile < M / 64; tile += G) {
        const int t0 = tile * 64 + tq * 16, tin = t0 & (SEQ - 1);
        float xm[3][8];
#pragma unroll
        for (int k = 1; k <= 3; ++k) {
            if (tin - k >= 0) { const u32x4 r = *(const GAS u32x4*)((const GAS bf16_t*)P + (size_t)(t0 - k) * 2048 + 1024 + c8);
                xm[3 - k][0] = bflo(r.x); xm[3 - k][1] = bfhi(r.x); xm[3 - k][2] = bflo(r.y); xm[3 - k][3] = bfhi(r.y); xm[3 - k][4] = bflo(r.z); xm[3 - k][5] = bfhi(r.z); xm[3 - k][6] = bflo(r.w); xm[3 - k][7] = bfhi(r.w); }
            else {
#pragma unroll
                for (int e = 0; e < 8; ++e) xm[3 - k][e] = 0.f; } }
#pragma unroll 4
        for (int i = 0; i < 16; ++i) {
            const u32x4 r = *(const GAS u32x4*)((const GAS bf16_t*)P + (size_t)(t0 + i) * 2048 + 1024 + c8);
            const float xv[8] = {bflo(r.x), bfhi(r.x), bflo(r.y), bfhi(r.y), bflo(r.z), bfhi(r.z), bflo(r.w), bfhi(r.w)};
            float y[8];
#pragma unroll
            for (int e = 0; e < 8; ++e) { y[e] = bias[e] + wgt[0][e] * xm[0][e] + wgt[1][e] * xm[1][e] + wgt[2][e] * xm[2][e] + wgt[3][e] * xv[e];
                xm[0][e] = xm[1][e]; xm[1][e] = xm[2][e]; xm[2][e] = xv[e]; }
            u32x4 wv; wv.x = pkbf(y[0], y[1]); wv.y = pkbf(y[2], y[3]); wv.z = pkbf(y[4], y[5]); wv.w = pkbf(y[6], y[7]);
            *(GAS u32x4*)((GAS bf16_t*)XC + (size_t)(t0 + i) * DM + c8) = wv; }
    }
}
__device__ __forceinline__ void lru_scan1(const int tid, const int bid, const int G, bf16_t* GL, const bf16_t* XC, const float* ba, const float* bx, const float* lam, float* segS, float* segB) {
    const int c2 = tid * 2, col = 256 * (c2 >> 7) + (c2 & 127);
    const float ba0 = ba[c2], ba1 = ba[c2 + 1], bx0 = bx[c2], bx1 = bx[c2 + 1];
    const float sp0 = -8.0f * log1pf(expf(-lam[c2])), sp1 = -8.0f * log1pf(expf(-lam[c2 + 1]));
    for (int u = bid; u < NB * 64; u += G) {
        const size_t row0 = (size_t)(u >> 6) * SEQ + (size_t)(u & 63) * 128;
        float h0 = 0.f, h1 = 0.f, s0 = 0.f, s1 = 0.f;
#pragma unroll 8
        for (int i = 0; i < 128; ++i) { GAS bf16_t* gp = (GAS bf16_t*)GL + (row0 + i) * 2048 + col;
            const unsigned r2 = *(const GAS unsigned*)gp, i2 = *(const GAS unsigned*)(gp + 128), x2 = *(const GAS unsigned*)((const GAS bf16_t*)XC + (row0 + i) * DM + c2);
            const float l0 = sigm(bflo(r2) + ba0) * sp0, l1 = sigm(bfhi(r2) + ba1) * sp1;
            float m0 = __builtin_amdgcn_sqrtf(fmaxf(1.0f - __expf(2.0f * l0), 0.0f)), m1 = __builtin_amdgcn_sqrtf(fmaxf(1.0f - __expf(2.0f * l1), 0.0f));
            if ((u & 63) == 0 && i == 0) { m0 = 1.0f; m1 = 1.0f; }
            const unsigned lp = pkbf(l0, l1), bp = pkbf(m0 * sigm(bflo(i2) + bx0) * bflo(x2), m1 * sigm(bfhi(i2) + bx1) * bfhi(x2));
            *(GAS unsigned*)gp = lp; *(GAS unsigned*)(gp + 128) = bp;
            const float q0 = bflo(lp), q1 = bfhi(lp);
            h0 = __expf(q0) * h0 + bflo(bp); h1 = __expf(q1) * h1 + bfhi(bp); s0 += q0; s1 += q1; }
        *(GAS f32x2_t*)((GAS float*)segS + (size_t)u * DM + c2) = (f32x2_t){s0, s1}; *(GAS f32x2_t*)((GAS float*)segB + (size_t)u * DM + c2) = (f32x2_t){h0, h1};
    }
}
__device__ __forceinline__ void lru_scan2(const int tid, const int bid, const int G, const bf16_t* GL, const float* segS, const float* segB, const bf16_t* P, bf16_t* Y) {
    const int c2 = tid * 2, col = 256 * (c2 >> 7) + (c2 & 127);
    for (int u = bid; u < NB * 64; u += G) {
        const int b = u >> 6, seg = (u & 256) ? 63 - (u & 63) : (u & 63);
        const size_t row0 = (size_t)b * SEQ + (size_t)seg * 128;
        float h0 = 0.f, h1 = 0.f;
#pragma unroll 8
        for (int s = 0; s < seg; ++s) { const f32x2_t ss = *(const GAS f32x2_t*)((const GAS float*)segS + (size_t)(b * 64 + s) * DM + c2), sb = *(const GAS f32x2_t*)((const GAS float*)segB + (size_t)(b * 64 + s) * DM + c2);
            h0 = __expf(ss.x) * h0 + sb.x; h1 = __expf(ss.y) * h1 + sb.y; }
#pragma unroll 8
        for (int i = 0; i < 128; ++i) { const GAS bf16_t* gp = (const GAS bf16_t*)GL + (row0 + i) * 2048 + col; const unsigned a2 = *(const GAS unsigned*)gp, b2 = *(const GAS unsigned*)(gp + 128), y2 = *(const GAS unsigned*)((const GAS bf16_t*)P + (row0 + i) * 2048 + c2);
            h0 = __expf(bflo(a2)) * h0 + bflo(b2); h1 = __expf(bfhi(a2)) * h1 + bfhi(b2);
            const float y0 = bflo(y2), y1 = bfhi(y2);
            const float g0 = y0 * sigm(1.5957691216057308f * (y0 + 0.044715f * y0 * y0 * y0)), g1 = y1 * sigm(1.5957691216057308f * (y1 + 0.044715f * y1 * y1 * y1));
            *(GAS unsigned*)((GAS bf16_t*)Y + (row0 + i) * DM + c2) = pkbf(g0 * h0, g1 * h1); }
    }
}

#define XB_TMO      128
#define XB_XCNT(j)  (256  + 64 * (j))
#define XB_XSUB(j)  (1280 + 64 * (j))
#define XB_XGEN(j)  (2304 + 64 * (j))
#define XB_TOP      3328
#define XB_TOPGEN   3392
#define XCD_BAR_WORDS 3456
#define XB_SPIN_CAP (1u << 22)
__device__ __forceinline__ unsigned xb_ld(unsigned* p)              { return __hip_atomic_load(p, __ATOMIC_RELAXED, __HIP_MEMORY_SCOPE_AGENT); }
__device__ __forceinline__ unsigned xb_add(unsigned* p, unsigned v) { return __hip_atomic_fetch_add(p, v, __ATOMIC_RELAXED, __HIP_MEMORY_SCOPE_AGENT); }
__device__ __forceinline__ unsigned xb_xcc_id() { return (unsigned)__builtin_amdgcn_s_getreg((3 << 11) | 20) & 0xFu; }
#define XB_SPIN(cond, bar) do { unsigned _sp = 0; while (cond) { __builtin_amdgcn_s_sleep(1); \
    if ((++_sp & 255u) == 0u) { if (xb_ld(&(bar)[XB_TMO])) break; if (_sp > XB_SPIN_CAP) { atomicAdd(&(bar)[XB_TMO], 1u); break; } } } } while (0)
struct XcdBarrier { unsigned* bar; unsigned x; volatile LAS unsigned* st; };
__device__ __forceinline__ void xcd_barrier_complete(unsigned* bar, unsigned x, unsigned& nloc, unsigned& nx) {
    const unsigned G = gridDim.x * gridDim.y * gridDim.z;
    unsigned sum, cnt, mine, sp = 0u;
    for (;;) {
        sum = 0u; cnt = 0u; mine = 0u;
#pragma unroll
        for (unsigned j = 0; j < 16; ++j) { const unsigned c = xb_ld(&bar[XB_XCNT(j)]); sum += c; cnt += (c > 0u) ? 1u : 0u; mine = (j == x) ? c : mine; }
        if (sum == G) break;
        __builtin_amdgcn_s_sleep(1);
        if ((++sp & 255u) == 0u) { if (xb_ld(&bar[XB_TMO])) break; if (sp > XB_SPIN_CAP) { atomicAdd(&bar[XB_TMO], 1u); break; } }
    }
    nloc = mine > 0u ? mine : 1u; nx = cnt > 0u ? cnt : 1u;
}
__device__ __forceinline__ void xcd_barrier(const XcdBarrier& b) {
    asm volatile("s_waitcnt vmcnt(0)" ::: "memory");
    __syncthreads();
    if (threadIdx.x == 0) {
        unsigned* bar = b.bar;
        __builtin_amdgcn_s_waitcnt(0);
        unsigned nloc = b.st[0], nx = b.st[1];
        if (nloc == 0u) { xcd_barrier_complete(bar, b.x, nloc, nx); b.st[0] = nloc; b.st[1] = nx; }
        const unsigned old = xb_add(&bar[XB_XSUB(b.x)], 1u);
        const unsigned gen = old / nloc;
        if (old + 1u == (gen + 1u) * nloc) {
            __builtin_amdgcn_fence(__ATOMIC_RELEASE, "agent");
            asm volatile("s_waitcnt vmcnt(0)" ::: "memory");
            const unsigned og = xb_add(&bar[XB_TOP], 1u);
            const unsigned tg = og / nx;
            if (og + 1u == (tg + 1u) * nx) xb_add(&bar[XB_TOPGEN], 1u);
            else XB_SPIN(xb_ld(&bar[XB_TOPGEN]) == tg, bar);
            __builtin_amdgcn_fence(__ATOMIC_ACQUIRE, "agent");
            xb_add(&bar[XB_XGEN(b.x)], 1u);
            asm volatile("s_waitcnt vmcnt(0)" ::: "memory");
        } else {
            XB_SPIN(xb_ld(&bar[XB_XGEN(b.x)]) == gen, bar);
            __builtin_amdgcn_fence(__ATOMIC_ACQUIRE, "agent");
            asm volatile("s_waitcnt vmcnt(0)" ::: "memory");
        }
    }
    __syncthreads();
}

enum { K_WEIGHTS = 0, K_NORM, K_G_SWIGLU, K_G_RESID, K_G_STORE, K_LA_PREP, K_LA_SCAN, K_LA_POST, K_ATTN, K_CONV, K_SCAN1, K_SCAN2, K_FINAL };
constexpr int NPH = 1 + (7 + 5) + (7 + 5) + (7 + 3) + (7 + 6) + 1;

__device__ __forceinline__ const float* inp(const Params& p, int k) { asm volatile("" : "+s"(k)); return (const float*)(const GAS float*)p.in[k]; }

__global__ void __launch_bounds__(512, 2) fwd_kernel(Params p) {
    extern __shared__ __attribute__((aligned(16))) unsigned char lds_raw[];
    unsigned char* lds = lds_raw;
    LAS unsigned char* lds3 = (LAS unsigned char*)lds_raw;
    const int wid_root = __builtin_amdgcn_readfirstlane(threadIdx.x >> 6);
    if (threadIdx.x < 2) ((volatile LAS unsigned*)(lds3 + LDS_BAR))[threadIdx.x] = 0u;
    if (threadIdx.x == 0) (void)xb_add(&((unsigned*)p.ws)[XB_XCNT(xb_xcc_id())], 1u);
    __syncthreads();
    for (int ph = p.ph_lo; ph < p.ph_hi; ++ph) {
        int wq = wid_root; asm volatile("" : "+s"(wq));
        int lane_; asm volatile("v_mbcnt_lo_u32_b32 %0, -1, 0\n\tv_mbcnt_hi_u32_b32 %0, -1, %0" : "=v"(lane_));
        const int tid = wq * 64 + lane_;
        int bid = blockIdx.x; asm volatile("" : "+s"(bid));
        int G = gridDim.x; asm volatile("" : "+s"(G));
        unsigned char* ws = p.ws; asm volatile("" : "+s"(ws)); ws = (unsigned char*)(GAS unsigned char*)ws;
        float* xout = p.out; asm volatile("" : "+s"(xout)); xout = (float*)(GAS float*)xout;
        bf16_t* Hb = (bf16_t*)(ws + WS_H);
        bf16_t* R1 = (bf16_t*)(ws + WS_R1);
        bf16_t* XR = (bf16_t*)(ws + WS_XR);
        float* SSP = (float*)(ws + WS_SSP);
        float* RSTD = (float*)(ws + WS_RSTD);
        int kind = K_FINAL, L = 0, sub = 0;
        if (ph == 0) kind = K_WEIGHTS;
        else { int q = ph - 1;
            for (int l = 0; l < 4; ++l) { const int cn = (l == 0 || l == 1) ? 12 : (l == 2 ? 10 : 13); if (q < cn) { L = l; sub = q; kind = -1; break; } q -= cn; } }
        int ffn = 0, nidx = 0, mix = -1, msub = 0;
        if (kind == -1) {
            const int mc = (L == 2) ? 3 : (L == 3 ? 6 : 5);
            if (sub == 0) { kind = K_NORM; nidx = 0; }
            else if (sub == 1) { kind = K_G_SWIGLU; ffn = 2 * L; }
            else if (sub == 2) { kind = K_G_RESID; ffn = 2 * L; }
            else if (sub == 3) { kind = K_NORM; nidx = 1; }
            else if (sub < 4 + mc) { mix = L; msub = sub - 4;
                if (L == 0 || L == 1) kind = msub == 0 ? K_G_STORE : msub == 1 ? K_LA_PREP : msub == 2 ? K_LA_SCAN : msub == 3 ? K_LA_POST : K_G_RESID;
                else if (L == 2) kind = msub == 0 ? K_G_STORE : msub == 1 ? K_ATTN : K_G_RESID;
                else kind = msub == 0 ? K_G_STORE : msub == 1 ? K_CONV : msub == 2 ? K_G_STORE : msub == 3 ? K_SCAN1 : msub == 4 ? K_SCAN2 : K_G_RESID; }
            else { const int s2 = sub - 4 - mc; if (s2 == 0) { kind = K_NORM; nidx = 2; } else if (s2 == 1) { kind = K_G_SWIGLU; ffn = 2 * L + 1; } else { kind = K_G_RESID; ffn = 2 * L + 1; } }
        }
        if (kind == K_NORM) continue;
        switch (kind) {
        case K_WEIGHTS: weights_phase(tid, bid, G, p, ws, lds); first_phase(tid, bid, G, inp(p, 0), XR, SSP); break;
        case K_NORM: rstd_phase(tid, bid, G, SSP, RSTD); break;
        case K_FINAL: final_phase(tid, bid, G, XR, SSP, xout, inp(p, 4)); break;
        case K_G_SWIGLU: {
            pg8::Gemm g{XR, (const bf16_t*)(ws + WS_W + ffn * FFN_STRIDE), M, 2 * FF, DM, DM, 0};
            pg8::StaticOrder S; S.init(M, 2 * FF, G, bid);
            pg8::EpiSwiGLU E{R1, SSP};
            pg8::gemm_phase<pg8::EpiSwiGLU>(tid, lds3, g, S, E);
        } break;
        case K_G_RESID: {
            pg8::Gemm g; float scale;
            if (mix < 0) { g = pg8::Gemm{R1, (const bf16_t*)(ws + WS_W + ffn * FFN_STRIDE + WD_OFF), M, DM, FF, FF, 0}; scale = 0.5f; }
            else { const size_t wo = mix == 0 ? WS_HG_OUT : mix == 1 ? WS_GL_OUT : mix == 2 ? WS_AT_OUT : WS_LR_OUT; g = pg8::Gemm{Hb, (const bf16_t*)(ws + wo), M, DM, DM, DM, 0}; scale = 1.0f; }
            pg8::StaticOrder S; S.init(M, DM, G, bid);
            pg8::EpiResid E{XR, scale, SSP, nullptr};
            pg8::gemm_phase<pg8::EpiResid>(tid, lds3, g, S, E);
        } break;
        case K_G_STORE: {
            const bool gate = (mix == 3 && msub == 2);
            const int N = mix == 0 ? 4096 : mix == 1 ? 3584 : mix == 2 ? 3072 : 2048;
            const size_t wi = mix == 0 ? WS_HG_IN : mix == 1 ? WS_GL_IN : mix == 2 ? WS_AT_IN : (gate ? WS_LR_GATE : WS_LR_IN);
            pg8::Gemm g{gate ? Hb : XR, (const bf16_t*)(ws + wi), M, N, gate ? 256 : DM, DM, gate ? 2 : 0};
            pg8::StaticOrder S; S.init(M, N, G, bid);
            pg8::EpiStore E{gate ? R1 + (size_t)M * 2048 : R1, N, gate ? (const float*)nullptr : (const float*)SSP};
            pg8::gemm_phase<pg8::EpiStore>(tid, lds3, g, S, E);
        } break;
        case K_LA_PREP:
            if (mix == 0) la_prep<0>(tid, bid, G, lds, R1, inp(p, 6), L, nullptr, (bf16_t*)(ws + WS_R2), (float*)(ws + WS_DL));
            else la_prep<1>(tid, bid, G, lds, R1, nullptr, L, inp(p, 12), (bf16_t*)(ws + WS_R2), (float*)(ws + WS_DL));
            break;
        case K_LA_SCAN:
            if (mix == 0) la_scan<0>(tid, bid, G, lds, R1, (const bf16_t*)(ws + WS_R2), (const float*)(ws + WS_DL), Hb);
            else la_scan<1>(tid, bid, G, lds, R1, (const bf16_t*)(ws + WS_R2), (const float*)(ws + WS_DL), Hb);
            break;
        case K_LA_POST:
            if (mix == 0) la_post<0>(tid, bid, G, Hb, R1, inp(p, 7)); else la_post<1>(tid, bid, G, Hb, R1, inp(p, 13));
            break;
        case K_ATTN: attn_phase(tid, bid, G, lds, R1, inp(p, 16), Hb); break;
        case K_CONV: conv_phase(tid, bid, G, R1, inp(p, 19), inp(p, 20), Hb); break;
        case K_SCAN1: lru_scan1(tid, bid, G, R1 + (size_t)M * 2048, Hb, inp(p, 22), inp(p, 24), inp(p, 25), (float*)(ws + WS_R2), (float*)(ws + WS_R2 + 4 * MiB)); break;
        case K_SCAN2: lru_scan2(tid, bid, G, R1 + (size_t)M * 2048, (const float*)(ws + WS_R2), (const float*)(ws + WS_R2 + 4 * MiB), R1, Hb); break;
        default: break;
        }
        if (ph + 1 < p.ph_hi) {
            if (ph == p.ph_lo) cg::this_grid().sync();
            else { XcdBarrier xb; xb.bar = (unsigned*)ws; xb.x = xb_xcc_id(); xb.st = (volatile LAS unsigned*)(lds3 + LDS_BAR); xcd_barrier(xb); }
        }
    }
}

extern "C" void kernel_launch(void* const* d_in, const int* in_sizes, int n_in, void* d_out, int out_size, void* d_ws, size_t ws_size, hipStream_t stream) {
    static int grid = 0;
    if (grid == 0) {
        if (n_in != 27 || out_size != M * DM || ws_size < WS_END) { fprintf(stderr, "kernel_launch: unexpected sizes (n_in %d, out %d, ws %zu; need ws >= %zu); nothing launched\n", n_in, out_size, ws_size, (size_t)WS_END); grid = -1; return; }
        int dev = 0, cus = 0, per_cu = 0;
        if (hipGetDevice(&dev) != hipSuccess || hipDeviceGetAttribute(&cus, hipDeviceAttributeMultiprocessorCount, dev) != hipSuccess) { grid = -1; return; }
        if (hipFuncSetAttribute((const void*)fwd_kernel, hipFuncAttributeMaxDynamicSharedMemorySize, LDS_BYTES) != hipSuccess) { fprintf(stderr, "kernel_launch: hipFuncSetAttribute failed\n"); grid = -1; return; }
        if (hipOccupancyMaxActiveBlocksPerMultiprocessor(&per_cu, (const void*)fwd_kernel, 512, LDS_BYTES) != hipSuccess || per_cu < 1) { fprintf(stderr, "kernel_launch: occupancy query says %d blocks per CU\n", per_cu); per_cu = 1; }
        (void)hipGetLastError();
        grid = cus;
    }
    if (grid < 0) return;
    if (hipMemsetAsync(d_ws, 0, 16384, stream) != hipSuccess) { fprintf(stderr, "kernel_launch: memset of the barrier words failed\n"); return; }
    Params p{};
    for (int i = 0; i < 27; ++i) p.in[i] = (const float*)d_in[i];
    p.out = (float*)d_out; p.ws = (unsigned char*)d_ws;
#if ONE_LAUNCH
    p.ph_lo = 0; p.ph_hi = NPH;
    void* args[] = {&p};
    hipError_t e = hipLaunchCooperativeKernel((const void*)fwd_kernel, dim3(grid), dim3(512), args, LDS_BYTES, stream);
    if (e != hipSuccess) fprintf(stderr, "kernel_launch: cooperative launch failed: %s (grid %d)\n", hipGetErrorString(e), grid);
#else
    for (int ph = 0; ph < NPH; ++ph) { p.ph_lo = ph; p.ph_hi = ph + 1; hipLaunchKernelGGL(fwd_kernel, dim3(grid), dim3(512), LDS_BYTES, stream, p); }
#endif
}
```

```cpp
#include <hip/hip_runtime.h>
#include <hip/hip_cooperative_groups.h>
#include <cstdio>
#include <cstdint>
namespace cg = cooperative_groups;

#ifndef ONE_LAUNCH
#define ONE_LAUNCH 1
#endif

#define LAS __attribute__((address_space(3)))
#define GAS __attribute__((address_space(1)))
typedef unsigned short bf16_t;
typedef short bf16x8 __attribute__((ext_vector_type(8)));
typedef float f32x4 __attribute__((ext_vector_type(4)));
typedef unsigned u32x4 __attribute__((ext_vector_type(4)));
typedef unsigned u32x2 __attribute__((ext_vector_type(2)));

constexpr int M = 65536, DM = 1024, FF = 2816, SEQ = 8192, NB = 8, NCHUNK = 128;
constexpr float EPS = 1e-6f;

constexpr size_t MiB = (size_t)1 << 20;
constexpr size_t WS_W = 2 * MiB;
constexpr size_t FFN_STRIDE = 17301504;
constexpr size_t WD_OFF = 11 * MiB;
constexpr size_t WS_HG_IN = 134 * MiB, WS_HG_OUT = 142 * MiB, WS_GL_IN = 144 * MiB, WS_GL_OUT = 151 * MiB, WS_AT_IN = 153 * MiB, WS_AT_OUT = 159 * MiB,
                 WS_LR_IN = 161 * MiB, WS_LR_GATE = 165 * MiB, WS_LR_OUT = 166 * MiB;
constexpr size_t WS_H = 168 * MiB;
constexpr size_t WS_R1 = 296 * MiB;
constexpr size_t WS_R2 = 808 * MiB;
constexpr size_t WS_DL = 872 * MiB;
constexpr size_t WS_XR = 876 * MiB;
constexpr size_t WS_SSP = 1004 * MiB;
constexpr size_t WS_RSTD = 1008 * MiB;
constexpr size_t WS_END = 1009 * MiB;
constexpr int LDS_STAT = 131072;
constexpr int LDS_BAR = 131072 + 2048;
constexpr int LDS_BYTES = 131072 + 2048 + 64;

__device__ __forceinline__ float bflo(unsigned u) { return __uint_as_float(u << 16); }
__device__ __forceinline__ float bfhi(unsigned u) { return __uint_as_float(u & 0xffff0000u); }
typedef float f32x2_t __attribute__((ext_vector_type(2)));
typedef __bf16 bf16x2_t __attribute__((ext_vector_type(2)));
__device__ __forceinline__ unsigned pkbf(float lo, float hi) { const f32x2_t v = {lo, hi}; const bf16x2_t b = __builtin_convertvector(v, bf16x2_t); return __builtin_bit_cast(unsigned, b); }
__device__ __forceinline__ float frcp(float x) { return __builtin_amdgcn_rcpf(x); }
__device__ __forceinline__ float sigm(float x) { return frcp(1.0f + __expf(-x)); }
__device__ __forceinline__ float silu(float x) { return x * sigm(x); }
__device__ __forceinline__ float shx(float v, int off, int lane) { return __int_as_float(__builtin_amdgcn_ds_bpermute((lane ^ off) << 2, __float_as_int(v))); }
__device__ __forceinline__ float wave_sum(float v, int lane) {
#pragma unroll
    for (int o = 1; o < 64; o <<= 1) v += shx(v, o, lane);
    return v;
}
#define MFMA16(a, b, c) __builtin_amdgcn_mfma_f32_16x16x32_bf16((a), (b), (c), 0, 0, 0)

namespace pg8 {
constexpr int BM = 256, BK = 64, HALF = 128, HTB = HALF * BK * 2, STAGE_BYTES = 8 * HTB, NXCD = 8, WGM = 8;
__host__ __device__ __forceinline__ int lds_byte(int r, int c) { const int st = (r >> 4) * 2 + (c >> 5), rr = r & 15, cc = c & 31, ob = rr * 64 + cc * 2; return st * 1024 + (ob ^ (((ob >> 9) & 1) << 5)); }
__host__ __device__ __forceinline__ void stage_rc(int b, int& R, int& C) { const int st = b / 1024, sb = b % 1024, swz = sb ^ (((sb >> 9) & 1) << 5); R = (st >> 1) * 16 + swz / 64; C = (st & 1) * 32 + (swz % 64) / 2; }
__host__ __device__ __forceinline__ int perm32(int rho) { const int n = rho >> 4, i = rho & 15; return 8 * (i >> 2) + 4 * n + (i & 3); }

struct Unit { int pm, pn; };
struct Gemm { const bf16_t* A; const bf16_t* Bt; int M, N, K, lda, acol_div; };

struct StaticOrder {
    int nM, nN, nwg, G, c;
    __device__ void init(int M_, int N_, int G_, int c_) { nM = M_ / BM; nN = N_ / BM; nwg = nM * nN; G = G_; c = c_; }
    __device__ bool next(int i, Unit& u) const {
        const long L = (long)i * G + c; if (L >= nwg) return false;
        int wgid = (int)L; { const int q = nwg / NXCD, r = nwg % NXCD, xcd = wgid % NXCD, off = wgid / NXCD; wgid = (xcd < r ? xcd * (q + 1) : r * (q + 1) + (xcd - r) * q) + off; }
        const int nig = WGM * nN, gid = wgid / nig, fm = gid * WGM, gsz = (nM - fm) < WGM ? (nM - fm) : WGM;
        u.pm = fm + ((wgid % nig) % gsz); u.pn = (wgid % nig) / gsz; return true;
    }
};


struct EpiStore {
    static constexpr bool HAS_RS = true;
    bf16_t* O; int ldc; const float* rstd;
    __device__ __forceinline__ void operator()(const f32x4 (&acc)[2][2][4][2], const Unit& u, int wr, int wc, int fr, int fq, LAS unsigned char* lds, int par) const {
        asm volatile("" : "+v"(fr), "+v"(fq));
        const int row0 = u.pm * BM + wr * 64 + fr, col0 = u.pn * BM + wc * 32 + 8 * fq;
#pragma unroll
        for (int ai = 0; ai < 2; ++ai)
#pragma unroll
            for (int m = 0; m < 4; ++m) { GAS bf16_t* rowp = (GAS bf16_t*)O + (size_t)(row0 + ai * HALF + m * 16) * ldc + col0;
                const float rs = rstd ? ((const LAS float*)(lds + LDS_STAT))[par * 256 + wr * 64 + fr + ai * HALF + m * 16] : 1.0f;
#pragma unroll
                for (int bj = 0; bj < 2; ++bj) { const f32x4 v0 = acc[ai][bj][m][0] * rs, v1 = acc[ai][bj][m][1] * rs;
                    u32x4 w; w.x = pkbf(v0[0], v0[1]); w.y = pkbf(v0[2], v0[3]); w.z = pkbf(v1[0], v1[1]); w.w = pkbf(v1[2], v1[3]);
                    *(GAS u32x4*)(rowp + bj * HALF) = w; } }
    }
};
struct EpiSwiGLU {
    static constexpr bool HAS_RS = true;
    bf16_t* O; const float* rstd;
    __device__ __forceinline__ void operator()(const f32x4 (&acc)[2][2][4][2], const Unit& u, int wr, int wc, int fr, int fq, LAS unsigned char* lds, int par) const {
        asm volatile("" : "+v"(fr), "+v"(fq));
        const int row0 = u.pm * BM + wr * 64 + fr, col0 = u.pn * HALF + wc * 32 + 8 * fq;
#pragma unroll
        for (int ai = 0; ai < 2; ++ai)
#pragma unroll
            for (int m = 0; m < 4; ++m) { GAS bf16_t* rowp = (GAS bf16_t*)O + (size_t)(row0 + ai * HALF + m * 16) * FF + col0;
                const float rs = ((const LAS float*)(lds + LDS_STAT))[par * 256 + wr * 64 + fr + ai * HALF + m * 16];
                unsigned r[4];
#pragma unroll
                for (int n = 0; n < 2; ++n)
#pragma unroll
                    for (int j = 0; j < 4; j += 2) {
                        const f32x2_t g2 = (f32x2_t){acc[ai][0][m][n][j], acc[ai][0][m][n][j + 1]} * rs, u2 = (f32x2_t){acc[ai][1][m][n][j], acc[ai][1][m][n][j + 1]} * rs;
                        const f32x2_t t = g2 * -1.4426950408889634f; f32x2_t e; e.x = __builtin_amdgcn_exp2f(t.x); e.y = __builtin_amdgcn_exp2f(t.y);
                        const f32x2_t d = e + 1.0f; f32x2_t q; q.x = __builtin_amdgcn_rcpf(d.x); q.y = __builtin_amdgcn_rcpf(d.y);
                        const f32x2_t o = (g2 * u2) * q; r[n * 2 + (j >> 1)] = pkbf(o.x, o.y); }
                u32x4 w; w.x = r[0]; w.y = r[1]; w.z = r[2]; w.w = r[3];
                *(GAS u32x4*)rowp = w; }
    }
};
struct EpiResid {
    static constexpr bool HAS_RS = false;
    bf16_t* X; float scale; float* ssp; const float* rstd;
    __device__ __forceinline__ void operator()(const f32x4 (&acc)[2][2][4][2], const Unit& u, int wr, int wc, int fr, int fq, LAS unsigned char* lds, int par) const {
        asm volatile("" : "+v"(fr), "+v"(fq));
        const int row0 = u.pm * BM + wr * 64 + fr, col0 = u.pn * BM + wc * 32 + 8 * fq, lane = fq * 16 + fr;
        GAS float* sslot = (GAS float*)ssp + (size_t)(u.pn * 4 + wc) * M;
#pragma unroll
        for (int ai = 0; ai < 2; ++ai) {
            GAS bf16_t* base = (GAS bf16_t*)X + (size_t)(row0 + ai * HALF) * DM + col0;
            u32x4 xv[4][2];
#pragma unroll
            for (int m = 0; m < 4; ++m)
#pragma unroll
                for (int bj = 0; bj < 2; ++bj) xv[m][bj] = *(const GAS u32x4*)(base + (size_t)m * 16 * DM + bj * HALF);
            asm volatile("" ::: "memory");
#pragma unroll
            for (int m = 0; m < 4; ++m) { float sq = 0.f;
#pragma unroll
                for (int bj = 0; bj < 2; ++bj) { const u32x4 x = xv[m][bj]; const f32x4 a0 = acc[ai][bj][m][0] * scale, a1 = acc[ai][bj][m][1] * scale;
                    u32x4 w; w.x = pkbf(bflo(x.x) + a0[0], bfhi(x.x) + a0[1]); w.y = pkbf(bflo(x.y) + a0[2], bfhi(x.y) + a0[3]);
                    w.z = pkbf(bflo(x.z) + a1[0], bfhi(x.z) + a1[1]); w.w = pkbf(bflo(x.w) + a1[2], bfhi(x.w) + a1[3]);
                    *(GAS u32x4*)(base + (size_t)m * 16 * DM + bj * HALF) = w;
                    const float e0 = bflo(w.x), e1 = bfhi(w.x), e2 = bflo(w.y), e3 = bfhi(w.y), e4 = bflo(w.z), e5 = bfhi(w.z), e6 = bflo(w.w), e7 = bfhi(w.w);
                    sq += ((e0 * e0 + e1 * e1) + (e2 * e2 + e3 * e3)) + ((e4 * e4 + e5 * e5) + (e6 * e6 + e7 * e7)); }
                sq += shx(sq, 16, lane); sq += shx(sq, 32, lane);
                if (fq == 0) sslot[row0 + ai * HALF + m * 16] = sq; }
            asm volatile("" ::: "memory");
        }
    }
};
template <class Epi>
__device__ __forceinline__ void gemm_phase(const int tid, LAS unsigned char* lds, const Gemm g, const StaticOrder& S, const Epi& E) {
    const int wid = __builtin_amdgcn_readfirstlane(tid >> 6), lane = tid & 63, wr = wid >> 2, wc = wid & 3, fr = lane & 15, fq = lane >> 4;
    const int K = g.K, nt = K / BK, lda = g.lda;
    unsigned voffA[2], voffB[2];
#pragma unroll
    for (int i = 0; i < 2; ++i) { int R, C; stage_rc(tid * 16 + i * 8192, R, C); const int Rb = (R & ~31) + perm32(R & 31);
        voffA[i] = (unsigned)(R * lda + C) * 2u; voffB[i] = (unsigned)(Rb * K + C) * 2u; }
    const size_t kstep = (size_t)(BK * 2);
    const size_t hstepA = (size_t)HALF * lda * 2, hstepB = (size_t)HALF * K * 2;
    const size_t tstepA = 2 * hstepA, tstepB = 2 * hstepB;
    const unsigned ldsw = (unsigned)wid * 1024u;
    const int aoff = lds_byte(wr * 64 + fr, fq * 8), boff = lds_byte(wc * 32 + fr, fq * 8);
#define PG8_SA(b, h) (((b) * 2 + (h)) * HTB)
#define PG8_SB(b, h) ((4 + (b) * 2 + (h)) * HTB)
#define PG8_STAGE(bufoff, gbase, voff) do { _Pragma("unroll") for (int _i = 0; _i < 2; ++_i) \
        __builtin_amdgcn_global_load_lds((const unsigned*)((const char*)(gbase) + (voff)[_i]), (LAS unsigned*)(lds + (bufoff) + ldsw + _i * 8192), 16, 0, 0); } while (0)
#define PG8_LDA(dst, b, h) do { _Pragma("unroll") for (int m = 0; m < 4; ++m) _Pragma("unroll") for (int k = 0; k < 2; ++k) dst[m][k] = *(const LAS bf16x8*)(lds + PG8_SA(b, h) + aoff + m * 2048 + k * 1024); } while (0)
#define PG8_LDB(dst, b, h) do { _Pragma("unroll") for (int n = 0; n < 2; ++n) _Pragma("unroll") for (int k = 0; k < 2; ++k) dst[n][k] = *(const LAS bf16x8*)(lds + PG8_SB(b, h) + boff + n * 2048 + k * 1024); } while (0)
#define PG8_MMA(ai, bj, At, Bt) do { __builtin_amdgcn_s_setprio(1); _Pragma("unroll") for (int m = 0; m < 4; ++m) _Pragma("unroll") for (int n = 0; n < 2; ++n) _Pragma("unroll") for (int k = 0; k < 2; ++k) \
        acc[ai][bj][m][n] = __builtin_amdgcn_mfma_f32_16x16x32_bf16(Bt[n][k], At[m][k], acc[ai][bj][m][n], 0, 0, 0); __builtin_amdgcn_s_setprio(0); } while (0)
#define PG8_WAIT_V(n) asm volatile("s_waitcnt vmcnt(" #n ")" ::: "memory")
#define PG8_WAIT_L(n) asm volatile("s_waitcnt lgkmcnt(" #n ")" ::: "memory")
#define PG8_BAR __builtin_amdgcn_s_barrier()
#define PG8_SCHED __builtin_amdgcn_sched_barrier(0)
#define PG8_ACOL(pn) ((size_t)(g.acol_div ? ((pn) / g.acol_div) * 512 : 0))
    Unit cur, nxt; int ui = 0;
    if (!S.next(0, cur)) return;
    f32x4 acc[2][2][4][2];
#pragma unroll
    for (int a = 0; a < 2; ++a)
#pragma unroll
        for (int b = 0; b < 2; ++b)
#pragma unroll
            for (int m = 0; m < 4; ++m)
#pragma unroll
                for (int n = 0; n < 2; ++n) acc[a][b][m][n] = (f32x4){0.f, 0.f, 0.f, 0.f};
    bf16x8 At[4][2], B0[2][2], B1[2][2];
    const char* cA = (const char*)g.A + (size_t)cur.pm * tstepA + PG8_ACOL(cur.pn); const char* cB = (const char*)g.Bt + (size_t)cur.pn * tstepB;
    int ppm = -1, ppar = 1;
#define PG8_PANEL(pm) do { if ((pm) != ppm) { ppm = (pm); ppar ^= 1; if (tid < 256) { const GAS float* sp_ = (const GAS float*)E.rstd + (size_t)(pm) * 256 + tid; float s0_ = 0.f, s1_ = 0.f; \
            _Pragma("unroll") for (int k_ = 0; k_ < 16; k_ += 2) { s0_ += sp_[(size_t)k_ * M]; s1_ += sp_[(size_t)(k_ + 1) * M]; } \
            ((LAS float*)(lds + LDS_STAT))[ppar * 256 + tid] = rsqrtf((s0_ + s1_) * (1.0f / DM) + EPS); } } } while (0)
    if constexpr (Epi::HAS_RS) { if (E.rstd) PG8_PANEL(cur.pm); }
    PG8_STAGE(PG8_SB(0, 0), cB, voffB); PG8_STAGE(PG8_SB(0, 1), cB + hstepB, voffB); PG8_STAGE(PG8_SA(0, 0), cA, voffA); PG8_STAGE(PG8_SA(0, 1), cA + hstepA, voffA);
    if (wr == 1) PG8_BAR;
    PG8_WAIT_V(2); PG8_BAR;
    PG8_STAGE(PG8_SB(1, 0), cB + kstep, voffB); PG8_STAGE(PG8_SA(1, 0), cA + kstep, voffA); PG8_STAGE(PG8_SB(1, 1), cB + hstepB + kstep, voffB);
    PG8_WAIT_V(6); PG8_BAR;
    for (;;) {
        const bool has_next = S.next(ui + 1, nxt);
        const char* nA = has_next ? (const char*)g.A + (size_t)nxt.pm * tstepA + PG8_ACOL(nxt.pn) : cA; const char* nB = has_next ? (const char*)g.Bt + (size_t)nxt.pn * tstepB : cB;
        for (int t = 0; t < nt; t += 2) {
            const bool last = (t == nt - 2);
            const char* a1 = cA + (size_t)(t + 1) * kstep;
            const char* a2 = last ? nA : cA + (size_t)(t + 2) * kstep; const char* b2 = last ? nB : cB + (size_t)(t + 2) * kstep;
            const char* a3 = a2 + kstep; const char* b3 = b2 + kstep;
            PG8_LDB(B0, 0, 0); PG8_LDB(B1, 0, 1); PG8_SCHED; PG8_LDA(At, 0, 0); PG8_STAGE(PG8_SA(1, 1), a1 + hstepA, voffA);
            PG8_WAIT_V(8); PG8_WAIT_L(0); PG8_BAR; PG8_MMA(0, 0, At, B0); PG8_MMA(0, 1, At, B1); PG8_BAR; PG8_SCHED;
            PG8_LDA(At, 0, 1); PG8_STAGE(PG8_SB(0, 0), b2, voffB); PG8_STAGE(PG8_SB(0, 1), b2 + hstepB, voffB); PG8_STAGE(PG8_SA(0, 0), a2, voffA);
            PG8_WAIT_V(8); PG8_WAIT_L(0); PG8_BAR; PG8_MMA(1, 0, At, B0); PG8_MMA(1, 1, At, B1); PG8_BAR; PG8_SCHED;
            PG8_LDB(B0, 1, 0); PG8_LDB(B1, 1, 1); PG8_SCHED; PG8_LDA(At, 1, 0); PG8_STAGE(PG8_SA(0, 1), a2 + hstepA, voffA);
            PG8_WAIT_V(8); PG8_WAIT_L(0); PG8_BAR; PG8_MMA(0, 0, At, B0); PG8_MMA(0, 1, At, B1); PG8_BAR; PG8_SCHED;
            PG8_LDA(At, 1, 1); PG8_STAGE(PG8_SB(1, 0), b3, voffB); PG8_STAGE(PG8_SB(1, 1), b3 + hstepB, voffB); PG8_STAGE(PG8_SA(1, 0), a3, voffA);
            PG8_WAIT_V(8); PG8_WAIT_L(0); PG8_BAR; PG8_MMA(1, 0, At, B0); PG8_MMA(1, 1, At, B1); PG8_BAR; PG8_SCHED;
        }
        if (wr == 0) PG8_BAR;
        E(acc, cur, wr, wc, fr, fq, lds, ppar);
        if (!has_next) break;
#pragma unroll
        for (int a = 0; a < 2; ++a)
#pragma unroll
            for (int b = 0; b < 2; ++b)
#pragma unroll
                for (int m = 0; m < 4; ++m)
#pragma unroll
                    for (int n = 0; n < 2; ++n) acc[a][b][m][n] = (f32x4){0.f, 0.f, 0.f, 0.f};
        cur = nxt; cA = nA; cB = nB; ++ui;
        if (wr == 1) PG8_BAR;
        if constexpr (Epi::HAS_RS) { if (E.rstd) PG8_PANEL(cur.pm); }
    }
    PG8_WAIT_V(0);
    PG8_BAR;
#undef PG8_SA
#undef PG8_SB
#undef PG8_STAGE
#undef PG8_LDA
#undef PG8_LDB
#undef PG8_MMA
#undef PG8_WAIT_V
#undef PG8_WAIT_L
#undef PG8_BAR
#undef PG8_SCHED
#undef PG8_ACOL
#undef PG8_PANEL
}
}

struct WJob { const float* src; const float* gain; int K, N, kind, aux; bf16_t* dst; };
struct Params { const float* in[27]; float* out; unsigned char* ws; int ph_lo, ph_hi; };

__device__ __forceinline__ const float* inp(const Params& p, int k);
__device__ __forceinline__ WJob wjob(const Params& p, unsigned char* ws, int j) {
    WJob w; w.kind = 0; w.aux = 0; w.gain = nullptr;
    const float* ng = inp(p, 3);
    if (j < 16) { const int f = j >> 1;
        if ((j & 1) == 0) { w.src = inp(p, 1) + (size_t)f * DM * 2 * FF; w.K = DM; w.N = 2 * FF; w.kind = 1; w.gain = ng + (size_t)((f >> 1) * 3 + ((f & 1) ? 2 : 0)) * DM; w.dst = (bf16_t*)(ws + WS_W + f * FFN_STRIDE); }
        else { w.src = inp(p, 2) + (size_t)f * FF * DM; w.K = FF; w.N = DM; w.dst = (bf16_t*)(ws + WS_W + f * FFN_STRIDE + WD_OFF); }
        return w; }
    switch (j) {
        case 16: w.src = inp(p, 5); w.gain = ng + (size_t)(0 * 3 + 1) * DM; w.K = DM; w.N = 4096; w.dst = (bf16_t*)(ws + WS_HG_IN); break;
        case 17: w.src = inp(p, 8); w.K = DM; w.N = DM; w.dst = (bf16_t*)(ws + WS_HG_OUT); break;
        case 18: w.src = inp(p, 9); w.gain = ng + (size_t)(1 * 3 + 1) * DM; w.K = DM; w.N = 3072; w.dst = (bf16_t*)(ws + WS_GL_IN); break;
        case 19: w.src = inp(p, 10); w.gain = ng + (size_t)(1 * 3 + 1) * DM; w.K = DM; w.N = 512; w.kind = 2; w.dst = (bf16_t*)(ws + WS_GL_IN) + (size_t)3072 * DM; break;
        case 20: w.src = inp(p, 14); w.K = DM; w.N = DM; w.dst = (bf16_t*)(ws + WS_GL_OUT); break;
        case 21: w.src = inp(p, 15); w.gain = ng + (size_t)(2 * 3 + 1) * DM; w.K = DM; w.N = 3072; w.dst = (bf16_t*)(ws + WS_AT_IN); break;
        case 22: w.src = inp(p, 17); w.K = DM; w.N = DM; w.dst = (bf16_t*)(ws + WS_AT_OUT); break;
        case 23: w.src = inp(p, 18); w.gain = ng + (size_t)(3 * 3 + 1) * DM; w.K = DM; w.N = 2048; w.dst = (bf16_t*)(ws + WS_LR_IN); break;
        case 32: w.src = inp(p, 26); w.K = DM; w.N = DM; w.dst = (bf16_t*)(ws + WS_LR_OUT); break;
        default: { const int q = j - 24, gsel = q >> 2, head = q & 3; w.src = inp(p, gsel ? 23 : 21) + (size_t)head * 65536; w.K = 256; w.N = 256; w.kind = 3; w.aux = q; w.dst = (bf16_t*)(ws + WS_LR_GATE); } break;
    }
    return w;
}
constexpr int NWJOBS = 33;

__device__ __forceinline__ void weights_phase(const int tid, const int bid, const int G, const Params& p, unsigned char* ws, unsigned char* lds) {
    const int lane = tid & 63, wid = __builtin_amdgcn_readfirstlane(tid >> 6);
    float* scr = (float*)(lds + wid * 8448);
    const int gw = bid * 8 + wid, NGW = G * 8;
    int base = 0;
    for (int j = 0; j < NWJOBS; ++j) {
        const WJob w = wjob(p, ws, j);
        const int nblk = w.N / 32, nitems = (w.K / 64) * nblk;
        int first = (gw - base % NGW + NGW) % NGW;
        for (int it = first; it < nitems; it += NGW) {
            const int kb = it / nblk, nb = it % nblk, k0 = 64 * kb, n0 = 32 * nb;
            if (w.kind == 2) {
                const float* wd = w.src; const float* wu = inp(p, 11);
#pragma unroll 4
                for (int i = 0; i < 32; ++i) { const int kk = 2 * i + (lane >> 5); float s = 0.f;
#pragma unroll
                    for (int r = 0; r < 16; ++r) s += wd[(size_t)(k0 + kk) * 16 + r] * wu[r * 512 + n0 + (lane & 31)];
                    scr[kk * 33 + (lane & 31)] = s; }
            } else {
#pragma unroll 8
                for (int i = 0; i < 32; ++i) { const int kk = 2 * i + (lane >> 5); scr[kk * 33 + (lane & 31)] = ((const GAS float*)w.src)[(size_t)(k0 + kk) * w.N + n0 + (lane & 31)]; }
            }
            int drow0 = n0;
            if (w.kind == 1) { const int jj = n0 < FF ? n0 : n0 - FF; drow0 = 256 * (jj >> 7) + (jj & 127) + (n0 < FF ? 0 : 128); }
            else if (w.kind == 3) { const int gsel = w.aux >> 2, head = w.aux & 3, c = 256 * head + n0; drow0 = 256 * (c >> 7) + 128 * gsel + (c & 127); }
            __builtin_amdgcn_wave_barrier();
            asm volatile("s_waitcnt lgkmcnt(0)" ::: "memory");
            const int c = lane & 7;
            f32x4 g0 = (f32x4){1.f, 1.f, 1.f, 1.f}, g1 = g0;
            if (w.gain) { g0 = *(const f32x4*)(w.gain + k0 + 8 * c); g1 = *(const f32x4*)(w.gain + k0 + 8 * c + 4); }
#pragma unroll
            for (int q = 0; q < 4; ++q) { const int n = (lane >> 3) + 8 * q; const float* s = scr + (8 * c) * 33 + n;
                u32x4 o; o.x = pkbf(s[0 * 33] * g0[0], s[1 * 33] * g0[1]); o.y = pkbf(s[2 * 33] * g0[2], s[3 * 33] * g0[3]); o.z = pkbf(s[4 * 33] * g1[0], s[5 * 33] * g1[1]); o.w = pkbf(s[6 * 33] * g1[2], s[7 * 33] * g1[3]);
                *(GAS u32x4*)((GAS bf16_t*)w.dst + (size_t)(drow0 + n) * w.K + k0 + 8 * c) = o; }
            asm volatile("s_waitcnt lgkmcnt(0)" ::: "memory");
            __builtin_amdgcn_wave_barrier();
        }
        base += nitems;
    }
}

__device__ __forceinline__ void first_phase(const int tid, const int bid, const int G, const float* src, bf16_t* xr, float* rstd) {
    const int lane = tid & 63, wid = __builtin_amdgcn_readfirstlane(tid >> 6);
    const int gw = bid * 8 + wid, NGW = G * 8;
    for (int row = gw; row < M; row += NGW) {
        const GAS f32x4* xp = (const GAS f32x4*)(src + (size_t)row * DM) + lane;
        f32x4 v[4]; float s = 0.f;
#pragma unroll
        for (int j = 0; j < 4; ++j) { v[j] = xp[64 * j]; s += (v[j].x * v[j].x + v[j].y * v[j].y) + (v[j].z * v[j].z + v[j].w * v[j].w); }
        s = wave_sum(s, lane);
        if (lane < 16) ((GAS float*)rstd)[(size_t)lane * M + row] = lane == 0 ? s : 0.f;
#pragma unroll
        for (int j = 0; j < 4; ++j) { u32x2 w; w.x = pkbf(v[j].x, v[j].y); w.y = pkbf(v[j].z, v[j].w); ((GAS u32x2*)(xr + (size_t)row * DM))[lane + 64 * j] = w; }
    }
}
__device__ __forceinline__ void rstd_phase(const int tid, const int bid, const int G, const float* ssp, float* rstd) {
    for (int row = bid * 512 + tid; row < M; row += G * 512) { float s0 = 0.f, s1 = 0.f;
#pragma unroll
        for (int k = 0; k < 16; k += 2) { s0 += ((const GAS float*)ssp)[(size_t)k * M + row]; s1 += ((const GAS float*)ssp)[(size_t)(k + 1) * M + row]; }
        ((GAS float*)rstd)[row] = rsqrtf((s0 + s1) * (1.0f / DM) + EPS); }
}
__device__ __forceinline__ void final_phase(const int tid, const int bid, const int G, const bf16_t* xr, const float* ssp, float* fdst, const float* gain) {
    const int lane = tid & 63, wid = __builtin_amdgcn_readfirstlane(tid >> 6);
    const int gw = bid * 8 + wid, NGW = G * 8;
    f32x4 gv[2][2];
#pragma unroll
    for (int j = 0; j < 2; ++j) { gv[j][0] = *(const f32x4*)(gain + 8 * lane + 512 * j); gv[j][1] = *(const f32x4*)(gain + 8 * lane + 512 * j + 4); }
    for (int row = gw; row < M; row += NGW) {
        const GAS bf16_t* xp = (const GAS bf16_t*)xr + (size_t)row * DM + 8 * lane;
        float sp = lane < 16 ? ((const GAS float*)ssp)[(size_t)lane * M + row] : 0.f;
        sp += shx(sp, 1, lane); sp += shx(sp, 2, lane); sp += shx(sp, 4, lane); sp += shx(sp, 8, lane);
        const float r = rsqrtf(__int_as_float(__builtin_amdgcn_readfirstlane(__float_as_int(sp))) * (1.0f / DM) + EPS);
#pragma unroll
        for (int j = 0; j < 2; ++j) { const u32x4 q = *(const GAS u32x4*)(xp + 512 * j);
            const float v[8] = {bflo(q.x), bfhi(q.x), bflo(q.y), bfhi(q.y), bflo(q.z), bfhi(q.z), bflo(q.w), bfhi(q.w)};
            GAS float* op = (GAS float*)fdst + (size_t)row * DM + 8 * lane + 512 * j;
            *(GAS f32x4*)op = (f32x4){v[0] * r * gv[j][0][0], v[1] * r * gv[j][0][1], v[2] * r * gv[j][0][2], v[3] * r * gv[j][0][3]};
            *(GAS f32x4*)(op + 4) = (f32x4){v[4] * r * gv[j][1][0], v[5] * r * gv[j][1][1], v[6] * r * gv[j][1][2], v[7] * r * gv[j][1][3]}; }
    }
}

template <int MODE>
__device__ __forceinline__ void la_prep(const int tid, const int bid, const int G, unsigned char* lds, bf16_t* P, const float* lbl, int layer, const float* gbias, bf16_t* Aout, float* dlast) {
    constexpr int H = MODE == 0 ? 8 : 4, ldp = MODE == 0 ? 4096 : 3584;
    const int lane = tid & 63, wid = __builtin_amdgcn_readfirstlane(tid >> 6), cp = lane, seg = wid, l15 = lane & 15, kq = lane >> 4;
    LAS bf16_t* sQ = (LAS bf16_t*)(LAS unsigned char*)lds; LAS bf16_t* sK = sQ + 64 * 136; LAS float* sTot = (LAS float*)(sK + 64 * 136);
    GAS bf16_t* Pg = (GAS bf16_t*)P; GAS bf16_t* Ag = (GAS bf16_t*)Aout; GAS float* Dg = (GAS float*)dlast; const GAS float* lblg = (const GAS float*)lbl; const GAS float* gbg = (const GAS float*)gbias;
    const float scale = 0.08838834764831845f;
    constexpr int nunits = NB * H * NCHUNK;
    unsigned nq[8], nk[8], nl[8];
#define LAP_FETCH(uu) do { const int c_ = (uu) & 127, h_ = ((uu) >> 7) % H, b_ = ((uu) >> 7) / H; const GAS bf16_t* rp_ = Pg + ((size_t)b_ * SEQ + (size_t)c_ * 64 + seg * 8) * ldp + 2 * cp + h_ * 128; \
        _Pragma("unroll") for (int i_ = 0; i_ < 8; ++i_) { nq[i_] = *(const GAS unsigned*)(rp_ + (size_t)i_ * ldp); nk[i_] = *(const GAS unsigned*)(rp_ + (size_t)i_ * ldp + (MODE == 0 ? 1024 : 512)); \
            if (MODE == 1) nl[i_] = *(const GAS unsigned*)(rp_ + (size_t)i_ * ldp + 3072); else nl[i_] = 0u; } } while (0)
    if (bid < nunits) LAP_FETCH(bid);
    for (int u = bid; u < nunits; u += G) {
        const int c = u & 127, h = (u >> 7) % H, b = (u >> 7) / H;
        const size_t row0 = (size_t)b * SEQ + (size_t)c * 64;
        const int qcol = h * 128, kcol = (MODE == 0 ? 1024 : 512) + h * 128;
        unsigned cq[8], ck[8], cl2[8];
#pragma unroll
        for (int i = 0; i < 8; ++i) { cq[i] = nq[i]; ck[i] = nk[i]; cl2[i] = nl[i]; }
        if (u + G < nunits) LAP_FETCH(u + G);
        const int ch0 = h * 128 + 2 * cp;
        float cc0 = 0.f, cc1 = 0.f;
        if (MODE == 0) {
#pragma unroll
            for (int e = 0; e < 2; ++e) { float v[5], mx = -1e30f;
#pragma unroll
                for (int q = 0; q < 5; ++q) { v[q] = lblg[q * DM + ch0 + e]; mx = fmaxf(mx, v[q]); }
                float den = 0.f, num = 0.f;
#pragma unroll
                for (int q = 0; q < 5; ++q) { const float ex = __expf(v[q] - mx); den += ex; if (q <= layer) num += ex; }
                const float lb = num / den; if (e == 0) cc0 = lb; else cc1 = lb; }
        } else { cc0 = gbg[ch0]; cc1 = gbg[ch0 + 1]; }
        float qv[8][2], kv[8][2], cl[8][2];
        float run0 = 0.f, run1 = 0.f;
#pragma unroll
        for (int i = 0; i < 8; ++i) { const int t = seg * 8 + i;
            const unsigned q2 = cq[i], k2 = ck[i];
            float g0, g1;
            if (MODE == 0) {
                qv[i][0] = silu(bflo(q2)); qv[i][1] = silu(bfhi(q2));
                const float f0 = cc0 + (1.0f - cc0) * sigm(bflo(k2)), f1 = cc1 + (1.0f - cc1) * sigm(bfhi(k2));
                kv[i][0] = 1.0f - f0; kv[i][1] = 1.0f - f1; g0 = __logf(f0); g1 = __logf(f1);
            } else {
                const unsigned l2 = cl2[i];
                qv[i][0] = bflo(q2); qv[i][1] = bfhi(q2); kv[i][0] = bflo(k2); kv[i][1] = bfhi(k2);
                const float z0 = bflo(l2) + cc0, z1 = bfhi(l2) + cc1;
                g0 = (fminf(z0, 0.f) - __logf(1.0f + __expf(-fabsf(z0)))) * 0.0625f; g1 = (fminf(z1, 0.f) - __logf(1.0f + __expf(-fabsf(z1)))) * 0.0625f;
            }
            run0 += g0; run1 += g1; cl[i][0] = run0; cl[i][1] = run1; }
        sTot[seg * 128 + 2 * cp] = run0; sTot[seg * 128 + 2 * cp + 1] = run1;
        __syncthreads();
        float pre0 = 0.f, pre1 = 0.f, ref0 = 0.f, ref1 = 0.f, last0 = 0.f, last1 = 0.f;
#pragma unroll
        for (int s = 0; s < 8; ++s) { const float a0 = sTot[s * 128 + 2 * cp], a1 = sTot[s * 128 + 2 * cp + 1];
            if (s < seg) { pre0 += a0; pre1 += a1; } if (s < 4) { ref0 += a0; ref1 += a1; } last0 += a0; last1 += a1; }
        unsigned kh0[4], kh1[4];
#pragma unroll
        for (int i = 0; i < 8; ++i) { const int t = seg * 8 + i;
            const float c0 = pre0 + cl[i][0], c1 = pre1 + cl[i][1];
            const float qs0 = qv[i][0] * scale, qs1 = qv[i][1] * scale;
            const float d0 = fminf(fmaxf(c0 - ref0, -80.f), 80.f), d1 = fminf(fmaxf(c1 - ref1, -80.f), 80.f);
            *(LAS unsigned*)(sQ + t * 136 + 2 * cp) = pkbf(qs0 * __expf(d0), qs1 * __expf(d1));
            *(LAS unsigned*)(sK + t * 136 + 2 * cp) = pkbf(kv[i][0] * __expf(-d0), kv[i][1] * __expf(-d1));
            *(GAS unsigned*)(Pg + (row0 + t) * ldp + qcol + 2 * cp) = pkbf(qs0 * __expf(c0), qs1 * __expf(c1));
            cl[i][0] = kv[i][0] * __expf(last0 - c0); cl[i][1] = kv[i][1] * __expf(last1 - c1); }
#pragma unroll
        for (int i = 0; i < 4; ++i) { kh0[i] = pkbf(cl[2 * i][0], cl[2 * i + 1][0]); kh1[i] = pkbf(cl[2 * i][1], cl[2 * i + 1][1]); }
        { GAS bf16_t* kp = Pg + (row0 + cp) * ldp + kcol + 8 * seg;
          *(GAS u32x4*)kp = (u32x4){kh0[0], kh0[1], kh0[2], kh0[3]}; *(GAS u32x4*)(kp + 64) = (u32x4){kh1[0], kh1[1], kh1[2], kh1[3]}; }
        if (seg == 0) { Dg[(size_t)u * 128 + 2 * cp] = __expf(last0); Dg[(size_t)u * 128 + 2 * cp + 1] = __expf(last1); }
        __syncthreads();
        { const int tt = wid >> 1;
#pragma unroll
          for (int sti = 0; sti < 2; ++sti) { const int st = 2 * (wid & 1) + sti;
            f32x4 acc = (f32x4){0.f, 0.f, 0.f, 0.f};
            if (st <= tt) {
#pragma unroll
                for (int ks = 0; ks < 4; ++ks) {
                    const bf16x8 a = *(const LAS bf16x8*)(sK + (st * 16 + l15) * 136 + ks * 32 + kq * 8);
                    const bf16x8 bq = *(const LAS bf16x8*)(sQ + (tt * 16 + l15) * 136 + ks * 32 + kq * 8);
                    acc = MFMA16(a, bq, acc); }
            }
            const int t = tt * 16 + l15, s0 = st * 16 + kq * 4;
            float v[4];
#pragma unroll
            for (int j = 0; j < 4; ++j) v[j] = (s0 + j <= t) ? acc[j] : 0.f;
            u32x2 w; w.x = pkbf(v[0], v[1]); w.y = pkbf(v[2], v[3]);
            *(GAS u32x2*)(Ag + (size_t)u * 4096 + t * 64 + s0) = w; } }
        __syncthreads();
    }
}

template <int MODE>
__device__ __forceinline__ void la_scan(const int tid, const int bid, const int G, unsigned char* lds, const bf16_t* P, const bf16_t* Ain, const float* dlast, bf16_t* O) {
    constexpr int H = MODE == 0 ? 8 : 4, ldp = MODE == 0 ? 4096 : 3584, DV = MODE == 0 ? 128 : 256, NVS = DV / 32;
    constexpr int BUF = 50176;
    const int lane = tid & 63, w = __builtin_amdgcn_readfirstlane(tid >> 6), l15 = lane & 15, kq = lane >> 4;
    const GAS bf16_t* Pg = (const GAS bf16_t*)P; const GAS bf16_t* Ag = (const GAS bf16_t*)Ain; const GAS float* Dg = (const GAS float*)dlast; GAS bf16_t* Og = (GAS bf16_t*)O;
    LAS unsigned char* l3 = (LAS unsigned char*)lds;
    LAS bf16_t* sS0 = (LAS bf16_t*)(l3 + 2 * BUF);
    constexpr int ntasks = NB * H * NVS;
    const int vcu = (G % 8 == 0) ? (bid % 8) * (G / 8) + bid / 8 : bid;
    for (int task = vcu; task < ntasks; task += G) {
        const int vs = task % NVS, h = (task / NVS) % H, b = task / (NVS * H);
        const int qcol = h * 128, kcol = (MODE == 0 ? 1024 : 512) + h * 128, vcol = (MODE == 0 ? 2048 : 1024) + h * DV + vs * 32, ocol = h * DV + vs * 32;
        const size_t u0 = (size_t)(b * H + h) * NCHUNK;
        const size_t rowb = (size_t)b * SEQ;
        __syncthreads();
        for (int i = tid; i < 32 * 136 / 2; i += 512) ((LAS unsigned*)sS0)[i] = 0u;
        u32x4 rA, rQ[2], rK[2]; u32x2 rV; float rD = 0.f;
#define LA_LOAD(c) do { const size_t r0_ = rowb + (size_t)(c) * 64; \
            rA = *(const GAS u32x4*)(Ag + (u0 + (c)) * 4096 + (tid >> 3) * 64 + (tid & 7) * 8); \
            _Pragma("unroll") for (int i_ = 0; i_ < 2; ++i_) { const int idx_ = tid + 512 * i_, r_ = idx_ >> 4, c8_ = (idx_ & 15) * 8; \
                rQ[i_] = *(const GAS u32x4*)(Pg + (r0_ + r_) * ldp + qcol + c8_); rK[i_] = *(const GAS u32x4*)(Pg + (r0_ + r_) * ldp + kcol + c8_); } \
            rV = *(const GAS u32x2*)(Pg + (r0_ + (tid >> 3)) * ldp + vcol + (tid & 7) * 4); \
            if (tid < 128) rD = Dg[(u0 + (c)) * 128 + tid]; } while (0)
#define LA_WRITE(buf) do { LAS unsigned char* bb_ = l3 + (buf) * BUF; LAS bf16_t* sA_ = (LAS bf16_t*)bb_; LAS bf16_t* sQ_ = (LAS bf16_t*)(bb_ + 9216); LAS bf16_t* sK_ = (LAS bf16_t*)(bb_ + 26624); LAS bf16_t* sV_ = (LAS bf16_t*)(bb_ + 45056); LAS float* sD_ = (LAS float*)(bb_ + 49664); \
            *(LAS u32x4*)(sA_ + (tid >> 3) * 72 + (tid & 7) * 8) = rA; \
            _Pragma("unroll") for (int i_ = 0; i_ < 2; ++i_) { const int idx_ = tid + 512 * i_, r_ = idx_ >> 4, c8_ = (idx_ & 15) * 8; \
                *(LAS u32x4*)(sQ_ + r_ * 136 + c8_) = rQ[i_]; *(LAS u32x4*)(sK_ + (2 * r_ + (c8_ >> 6)) * 72 + (c8_ & 63)) = rK[i_]; } \
            { const int s_ = tid >> 3, v4_ = (tid & 7) * 4; sV_[(v4_ + 0) * 72 + s_] = (bf16_t)(rV.x & 0xffffu); sV_[(v4_ + 1) * 72 + s_] = (bf16_t)(rV.x >> 16); \
              sV_[(v4_ + 2) * 72 + s_] = (bf16_t)(rV.y & 0xffffu); sV_[(v4_ + 3) * 72 + s_] = (bf16_t)(rV.y >> 16); } \
            if (tid < 128) sD_[tid] = rD; } while (0)
        LA_LOAD(0);
        LA_WRITE(0);
        __syncthreads();
        f32x4 st[2]; st[0] = (f32x4){0.f, 0.f, 0.f, 0.f}; st[1] = (f32x4){0.f, 0.f, 0.f, 0.f};
        const int tt = w >> 1, vt = w & 1;
        for (int c = 0; c < NCHUNK; ++c) {
            const int cur = c & 1;
            if (c + 1 < NCHUNK) LA_LOAD(c + 1);
            const LAS unsigned char* bb = l3 + cur * BUF;
            const LAS bf16_t* sS = sS0 + cur * (32 * 136); LAS bf16_t* sSn = sS0 + (cur ^ 1) * (32 * 136);
            const LAS bf16_t* sA = (const LAS bf16_t*)bb; const LAS bf16_t* sQ = (const LAS bf16_t*)(bb + 9216); const LAS bf16_t* sK = (const LAS bf16_t*)(bb + 26624); const LAS bf16_t* sV = (const LAS bf16_t*)(bb + 45056); const LAS float* sD = (const LAS float*)(bb + 49664);
            f32x4 o = (f32x4){0.f, 0.f, 0.f, 0.f};
#pragma unroll
            for (int ks = 0; ks < 2; ++ks) {
                const bf16x8 a = *(const LAS bf16x8*)(sV + (vt * 16 + l15) * 72 + ks * 32 + kq * 8);
                const bf16x8 bq = *(const LAS bf16x8*)(sA + (tt * 16 + l15) * 72 + ks * 32 + kq * 8);
                o = MFMA16(a, bq, o); }
#pragma unroll
            for (int ks = 0; ks < 4; ++ks) {
                const bf16x8 a = *(const LAS bf16x8*)(sS + (vt * 16 + l15) * 136 + ks * 32 + kq * 8);
                const bf16x8 bq = *(const LAS bf16x8*)(sQ + (tt * 16 + l15) * 136 + ks * 32 + kq * 8);
                o = MFMA16(a, bq, o); }
            { u32x2 wv; wv.x = pkbf(o[0], o[1]); wv.y = pkbf(o[2], o[3]);
              *(GAS u32x2*)(Og + (rowb + (size_t)c * 64 + tt * 16 + l15) * DM + ocol + vt * 16 + kq * 4) = wv; }
            const float dk = sD[w * 16 + l15];
#pragma unroll
            for (int v2 = 0; v2 < 2; ++v2) {
                st[v2] = st[v2] * dk;
#pragma unroll
                for (int ks = 0; ks < 2; ++ks) {
                    const bf16x8 a = *(const LAS bf16x8*)(sV + (v2 * 16 + l15) * 72 + ks * 32 + kq * 8);
                    const bf16x8 bk = *(const LAS bf16x8*)(sK + (w * 16 + l15) * 72 + ks * 32 + kq * 8);
                    st[v2] = MFMA16(a, bk, st[v2]); } }
#pragma unroll
            for (int v2 = 0; v2 < 2; ++v2) {
                const unsigned p01 = pkbf(st[v2][0], st[v2][1]), p23 = pkbf(st[v2][2], st[v2][3]);
                LAS bf16_t* sp = sSn + (v2 * 16 + kq * 4) * 136 + w * 16 + l15;
                sp[0] = (bf16_t)(p01 & 0xffffu); sp[136] = (bf16_t)(p01 >> 16); sp[272] = (bf16_t)(p23 & 0xffffu); sp[408] = (bf16_t)(p23 >> 16); }
            if (c + 1 < NCHUNK) LA_WRITE(cur ^ 1);
            __syncthreads();
        }
#undef LA_LOAD
#undef LA_WRITE
    }
}

template <int MODE>
__device__ __forceinline__ void la_post(const int tid, const int bid, const int G, bf16_t* O, const bf16_t* P, const float* gain) {
    constexpr int ldp = MODE == 0 ? 4096 : 3584, DV = MODE == 0 ? 128 : 256, GRP = DV / 16, gcol = MODE == 0 ? 3072 : 2048;
    const int lane = tid & 63, wid = __builtin_amdgcn_readfirstlane(tid >> 6);
    const int gw = bid * 8 + wid, NGW = G * 8;
    float gn[16];
#pragma unroll
    for (int e = 0; e < 16; ++e) gn[e] = gain[(lane % GRP) * 16 + e];
    for (int row = gw; row < M; row += NGW) {
        GAS bf16_t* op = (GAS bf16_t*)O + (size_t)row * DM + lane * 16; const GAS bf16_t* gp = (const GAS bf16_t*)P + (size_t)row * ldp + gcol + lane * 16;
        const u32x4 o0 = *(const GAS u32x4*)op, o1 = *(const GAS u32x4*)(op + 8), g0 = *(const GAS u32x4*)gp, g1 = *(const GAS u32x4*)(gp + 8);
        const float ov[16] = {bflo(o0.x), bfhi(o0.x), bflo(o0.y), bfhi(o0.y), bflo(o0.z), bfhi(o0.z), bflo(o0.w), bfhi(o0.w),
                              bflo(o1.x), bfhi(o1.x), bflo(o1.y), bfhi(o1.y), bflo(o1.z), bfhi(o1.z), bflo(o1.w), bfhi(o1.w)};
        const float gv[16] = {bflo(g0.x), bfhi(g0.x), bflo(g0.y), bfhi(g0.y), bflo(g0.z), bfhi(g0.z), bflo(g0.w), bfhi(g0.w),
                              bflo(g1.x), bfhi(g1.x), bflo(g1.y), bfhi(g1.y), bflo(g1.z), bfhi(g1.z), bflo(g1.w), bfhi(g1.w)};
        float ss = 0.f;
#pragma unroll
        for (int e = 0; e < 16; ++e) ss += ov[e] * ov[e];
#pragma unroll
        for (int off = 1; off < GRP; off <<= 1) ss += shx(ss, off, lane);
        const float r = rsqrtf(ss * (1.0f / DV) + EPS);
        float y[16];
#pragma unroll
        for (int e = 0; e < 16; ++e) y[e] = ov[e] * r * gn[e] * silu(gv[e]);
        u32x4 w0, w1; w0.x = pkbf(y[0], y[1]); w0.y = pkbf(y[2], y[3]); w0.z = pkbf(y[4], y[5]); w0.w = pkbf(y[6], y[7]);
        w1.x = pkbf(y[8], y[9]); w1.y = pkbf(y[10], y[11]); w1.z = pkbf(y[12], y[13]); w1.w = pkbf(y[14], y[15]);
        *(GAS u32x4*)op = w0; *(GAS u32x4*)(op + 8) = w1;
    }
}

__device__ __forceinline__ void attn_tile(const LAS bf16_t* kb, const LAS bf16_t* vb, const LAS float* sB, const bf16x8 (&qf)[2][2], f32x4 (&oacc)[4][2], float (&mrow)[2], float (&lrow)[2],
                                          const int kc, const int qpos0, const int lane, const int l15, const int kq) {
    f32x4 s[4][2];
#pragma unroll
    for (int kt = 0; kt < 4; ++kt) {
        const bf16x8 ka0 = *(const LAS bf16x8*)(kb + (kt * 16 + l15) * 72 + kq * 8), ka1 = *(const LAS bf16x8*)(kb + (kt * 16 + l15) * 72 + 32 + kq * 8);
#pragma unroll
        for (int qt = 0; qt < 2; ++qt) { f32x4 z = (f32x4){0.f, 0.f, 0.f, 0.f}; z = MFMA16(ka0, qf[qt][0], z); s[kt][qt] = MFMA16(ka1, qf[qt][1], z); } }
#pragma unroll
    for (int qt = 0; qt < 2; ++qt) {
        const int qp = qpos0 + qt * 16 + l15;
        float mx = -1e30f;
#pragma unroll
        for (int kt = 0; kt < 4; ++kt)
#pragma unroll
            for (int j = 0; j < 4; ++j) { int d = qp - (kc * 64 + kt * 16 + kq * 4 + j); d = d < -63 ? -63 : (d > 128 ? 128 : d);
                const float val = s[kt][qt][j] * 0.125f + sB[d + 63]; s[kt][qt][j] = val; mx = fmaxf(mx, val); }
        mx = fmaxf(mx, shx(mx, 16, lane)); mx = fmaxf(mx, shx(mx, 32, lane));
        const float mnew = fmaxf(mrow[qt], mx), alpha = __expf(mrow[qt] - mnew); mrow[qt] = mnew;
        float ps = 0.f;
#pragma unroll
        for (int kt = 0; kt < 4; ++kt)
#pragma unroll
            for (int j = 0; j < 4; ++j) { const float pv = __expf(s[kt][qt][j] - mnew); s[kt][qt][j] = pv; ps += pv; }
        lrow[qt] = lrow[qt] * alpha + ps;
#pragma unroll
        for (int dt = 0; dt < 4; ++dt) oacc[dt][qt] = oacc[dt][qt] * alpha;
    }
#pragma unroll
    for (int kk = 0; kk < 2; ++kk) {
        bf16x8 pb[2];
#pragma unroll
        for (int qt = 0; qt < 2; ++qt) { const f32x4 a = s[2 * kk][qt], c2 = s[2 * kk + 1][qt];
            const u32x4 pw = (u32x4){pkbf(a[0], a[1]), pkbf(a[2], a[3]), pkbf(c2[0], c2[1]), pkbf(c2[2], c2[3])}; pb[qt] = __builtin_bit_cast(bf16x8, pw); }
#pragma unroll
        for (int dt = 0; dt < 4; ++dt) {
            const LAS bf16_t* vp = vb + (dt * 16 + l15) * 72 + kk * 32 + kq * 4;
            const u32x2 lo = *(const LAS u32x2*)vp, hi = *(const LAS u32x2*)(vp + 16);
            const bf16x8 va = __builtin_bit_cast(bf16x8, ((u32x4){lo.x, lo.y, hi.x, hi.y}));
            oacc[dt][0] = MFMA16(va, pb[0], oacc[dt][0]); oacc[dt][1] = MFMA16(va, pb[1], oacc[dt][1]); }
    }
}
__device__ __forceinline__ void attn_phase(const int tid, const int bid, const int G, unsigned char* lds, const bf16_t* P, const float* relb, bf16_t* O) {
    const int lane = tid & 63, w = __builtin_amdgcn_readfirstlane(tid >> 6), l15 = lane & 15, kq = lane >> 4;
    LAS bf16_t* sK = (LAS bf16_t*)(LAS unsigned char*)lds; LAS bf16_t* sV = sK + 2 * 64 * 72; LAS float* sB = (LAS float*)(sV + 2 * 64 * 72);
    constexpr int nunits = NB * 16 * 32, ldp = 3072;
    const GAS bf16_t* Pg = (const GAS bf16_t*)P; const GAS float* relg = (const GAS float*)relb; GAS bf16_t* Og = (GAS bf16_t*)O;
    const int skey = tid >> 3, sd8 = (tid & 7) * 8;
    const int vcu = (G % 8 == 0) ? (bid % 8) * (G / 8) + bid / 8 : bid;
    const int upb = (nunits + G - 1) / G;
    for (int u = vcu * upb; u < nunits && u < (vcu + 1) * upb; ++u) {
        const int qg = u & 31, h = (u >> 5) & 15, b = u >> 9;
        const int cw = qg * 4 + (w >> 1);
        const size_t seq0 = (size_t)b * SEQ;
        const int qpos0 = qg * 256 + w * 32;
        __syncthreads();
        if (tid < 192) sB[tid] = relg[h * 192 + tid];
        bf16x8 qf[2][2];
#pragma unroll
        for (int qt = 0; qt < 2; ++qt)
#pragma unroll
            for (int ks = 0; ks < 2; ++ks) qf[qt][ks] = *(const GAS bf16x8*)(Pg + (seq0 + qpos0 + qt * 16 + l15) * ldp + h * 64 + ks * 32 + kq * 8);
        f32x4 oacc[4][2];
#pragma unroll
        for (int dt = 0; dt < 4; ++dt) { oacc[dt][0] = (f32x4){0.f, 0.f, 0.f, 0.f}; oacc[dt][1] = (f32x4){0.f, 0.f, 0.f, 0.f}; }
        float mrow[2] = {-1e30f, -1e30f}, lrow[2] = {0.f, 0.f};
        const int kc0 = qg * 4 - 8 < 0 ? 0 : qg * 4 - 8, kc1 = qg * 4 + 3;
        u32x4 kA, vA, kB, vB;
#define AT_LOAD(KR, VR, kc) do { const GAS bf16_t* kp_ = Pg + (seq0 + (size_t)(kc) * 64 + skey) * ldp + 1024 + h * 64 + sd8; KR = *(const GAS u32x4*)kp_; VR = *(const GAS u32x4*)(kp_ + 1024); } while (0)
#define AT_WRITE(KR, VR, buf) do { LAS bf16_t* kb_ = sK + (buf) * 64 * 72; LAS bf16_t* vb_ = sV + (buf) * 64 * 72; *(LAS u32x4*)(kb_ + skey * 72 + sd8) = KR; \
            vb_[(sd8 + 0) * 72 + skey] = (bf16_t)(VR.x & 0xffffu); vb_[(sd8 + 1) * 72 + skey] = (bf16_t)(VR.x >> 16); vb_[(sd8 + 2) * 72 + skey] = (bf16_t)(VR.y & 0xffffu); vb_[(sd8 + 3) * 72 + skey] = (bf16_t)(VR.y >> 16); \
            vb_[(sd8 + 4) * 72 + skey] = (bf16_t)(VR.z & 0xffffu); vb_[(sd8 + 5) * 72 + skey] = (bf16_t)(VR.z >> 16); vb_[(sd8 + 6) * 72 + skey] = (bf16_t)(VR.w & 0xffffu); vb_[(sd8 + 7) * 72 + skey] = (bf16_t)(VR.w >> 16); } while (0)
#define AT_ITER(kc, KL, VL, KW, VW) do { const int cur_ = ((kc) - kc0) & 1; \
            if ((kc) + 2 <= kc1) AT_LOAD(KL, VL, (kc) + 2); \
            if ((kc) >= cw - 8 && (kc) <= cw) attn_tile(sK + cur_ * 64 * 72, sV + cur_ * 64 * 72, sB, qf, oacc, mrow, lrow, (kc), qpos0, lane, l15, kq); \
            if ((kc) + 1 <= kc1) AT_WRITE(KW, VW, cur_ ^ 1); \
            __syncthreads(); } while (0)
        AT_LOAD(kA, vA, kc0);
        AT_WRITE(kA, vA, 0);
        if (kc0 + 1 <= kc1) AT_LOAD(kA, vA, kc0 + 1);
        __syncthreads();
        for (int kc = kc0; kc <= kc1; kc += 2) {
            AT_ITER(kc, kB, vB, kA, vA);
            if (kc + 1 <= kc1) AT_ITER(kc + 1, kA, vA, kB, vB);
        }
#undef AT_LOAD
#undef AT_WRITE
#undef AT_ITER
#pragma unroll
        for (int qt = 0; qt < 2; ++qt) { float lt = lrow[qt]; lt += shx(lt, 16, lane); lt += shx(lt, 32, lane); const float inv = 1.0f / lt;
#pragma unroll
            for (int dt = 0; dt < 4; ++dt) { const f32x4 ov = oacc[dt][qt] * inv; u32x2 wv; wv.x = pkbf(ov[0], ov[1]); wv.y = pkbf(ov[2], ov[3]);
                *(GAS u32x2*)(Og + (seq0 + qpos0 + qt * 16 + l15) * DM + h * 64 + dt * 16 + kq * 4) = wv; } }
    }
}

__device__ __forceinline__ void conv_phase(const int tid, const int bid, const int G, const bf16_t* P, const float* cw, const float* cb, bf16_t* XC) {
    const int c8 = (tid & 127) * 8, tq = tid >> 7;
    float wgt[4][8], bias[8];
#pragma unroll
    for (int e = 0; e < 8; ++e) { bias[e] = cb[c8 + e];
#pragma unroll
        for (int j = 0; j < 4; ++j) wgt[j][e] = cw[j * DM + c8 + e]; }
    for (int tile = bid; tile < M / 64; tile += G) {
        const int t0 = tile * 64 + tq * 16, tin = t0 & (SEQ - 1);
        float xm[3][8];
#pragma unroll
        for (int k = 1; k <= 3; ++k) {
            if (tin - k >= 0) { const u32x4 r = *(const GAS u32x4*)((const GAS bf16_t*)P + (size_t)(t0 - k) * 2048 + 1024 + c8);
                xm[3 - k][0] = bflo(r.x); xm[3 - k][1] = bfhi(r.x); xm[3 - k][2] = bflo(r.y); xm[3 - k][3] = bfhi(r.y); xm[3 - k][4] = bflo(r.z); xm[3 - k][5] = bfhi(r.z); xm[3 - k][6] = bflo(r.w); xm[3 - k][7] = bfhi(r.w); }
            else {
#pragma unroll
                for (int e = 0; e < 8; ++e) xm[3 - k][e] = 0.f; } }
#pragma unroll 4
        for (int i = 0; i < 16; ++i) {
            const u32x4 r = *(const GAS u32x4*)((const GAS bf16_t*)P + (size_t)(t0 + i) * 2048 + 1024 + c8);
            const float xv[8] = {bflo(r.x), bfhi(r.x), bflo(r.y), bfhi(r.y), bflo(r.z), bfhi(r.z), bflo(r.w), bfhi(r.w)};
            float y[8];
#pragma unroll
            for (int e = 0; e < 8; ++e) { y[e] = bias[e] + wgt[0][e] * xm[0][e] + wgt[1][e] * xm[1][e] + wgt[2][e] * xm[2][e] + wgt[3][e] * xv[e];
                xm[0][e] = xm[1][e]; xm[1][e] = xm[2][e]; xm[2][e] = xv[e]; }
            u32x4 wv; wv.x = pkbf(y[0], y[1]); wv.y = pkbf(y[2], y[3]); wv.z = pkbf(y[4], y[5]); wv.w = pkbf(y[6], y[7]);
            *(GAS u32x4*)((GAS bf16_t*)XC + (size_t)(t0 + i) * DM + c8) = wv; }
    }
}
__device__ __forceinline__ void lru_scan1(const int tid, const int bid, const int G, bf16_t* GL, const bf16_t* XC, const float* ba, const float* bx, const float* lam, float* segS, float* segB) {
    const int c2 = tid * 2, col = 256 * (c2 >> 7) + (c2 & 127);
    const float ba0 = ba[c2], ba1 = ba[c2 + 1], bx0 = bx[c2], bx1 = bx[c2 + 1];
    const float sp0 = -8.0f * log1pf(expf(-lam[c2])), sp1 = -8.0f * log1pf(expf(-lam[c2 + 1]));
    for (int u = bid; u < NB * 64; u += G) {
        const size_t row0 = (size_t)(u >> 6) * SEQ + (size_t)(u & 63) * 128;
        float h0 = 0.f, h1 = 0.f, s0 = 0.f, s1 = 0.f;
#pragma unroll 8
        for (int i = 0; i < 128; ++i) { GAS bf16_t* gp = (GAS bf16_t*)GL + (row0 + i) * 2048 + col;
            const unsigned r2 = *(const GAS unsigned*)gp, i2 = *(const GAS unsigned*)(gp + 128), x2 = *(const GAS unsigned*)((const GAS bf16_t*)XC + (row0 + i) * DM + c2);
            const float l0 = sigm(bflo(r2) + ba0) * sp0, l1 = sigm(bfhi(r2) + ba1) * sp1;
            float m0 = __builtin_amdgcn_sqrtf(fmaxf(1.0f - __expf(2.0f * l0), 0.0f)), m1 = __builtin_amdgcn_sqrtf(fmaxf(1.0f - __expf(2.0f * l1), 0.0f));
            if ((u & 63) == 0 && i == 0) { m0 = 1.0f; m1 = 1.0f; }
            const unsigned lp = pkbf(l0, l1), bp = pkbf(m0 * sigm(bflo(i2) + bx0) * bflo(x2), m1 * sigm(bfhi(i2) + bx1) * bfhi(x2));
            *(GAS unsigned*)gp = lp; *(GAS unsigned*)(gp + 128) = bp;
            const float q0 = bflo(lp), q1 = bfhi(lp);
            h0 = __expf(q0) * h0 + bflo(bp); h1 = __expf(q1) * h1 + bfhi(bp); s0 += q0; s1 += q1; }
        *(GAS f32x2_t*)((GAS float*)segS + (size_t)u * DM + c2) = (f32x2_t){s0, s1}; *(GAS f32x2_t*)((GAS float*)segB + (size_t)u * DM + c2) = (f32x2_t){h0, h1};
    }
}
__device__ __forceinline__ void lru_scan2(const int tid, const int bid, const int G, const bf16_t* GL, const float* segS, const float* segB, const bf16_t* P, bf16_t* Y) {
    const int c2 = tid * 2, col = 256 * (c2 >> 7) + (c2 & 127);
    for (int u = bid; u < NB * 64; u += G) {
        const int b = u >> 6, seg = (u & 256) ? 63 - (u & 63) : (u & 63);
        const size_t row0 = (size_t)b * SEQ + (size_t)seg * 128;
        float h0 = 0.f, h1 = 0.f;
#pragma unroll 8
        for (int s = 0; s < seg; ++s) { const f32x2_t ss = *(const GAS f32x2_t*)((const GAS float*)segS + (size_t)(b * 64 + s) * DM + c2), sb = *(const GAS f32x2_t*)((const GAS float*)segB + (size_t)(b * 64 + s) * DM + c2);
            h0 = __expf(ss.x) * h0 + sb.x; h1 = __expf(ss.y) * h1 + sb.y; }
#pragma unroll 8
        for (int i = 0; i < 128; ++i) { const GAS bf16_t* gp = (const GAS bf16_t*)GL + (row0 + i) * 2048 + col; const unsigned a2 = *(const GAS unsigned*)gp, b2 = *(const GAS unsigned*)(gp + 128), y2 = *(const GAS unsigned*)((const GAS bf16_t*)P + (row0 + i) * 2048 + c2);
            h0 = __expf(bflo(a2)) * h0 + bflo(b2); h1 = __expf(bfhi(a2)) * h1 + bfhi(b2);
            const float y0 = bflo(y2), y1 = bfhi(y2);
            const float g0 = y0 * sigm(1.5957691216057308f * (y0 + 0.044715f * y0 * y0 * y0)), g1 = y1 * sigm(1.5957691216057308f * (y1 + 0.044715f * y1 * y1 * y1));
            *(GAS unsigned*)((GAS bf16_t*)Y + (row0 + i) * DM + c2) = pkbf(g0 * h0, g1 * h1); }
    }
}

#define XB_TMO      128
#define XB_XCNT(j)  (256  + 64 * (j))
#define XB_XSUB(j)  (1280 + 64 * (j))
#define XB_XGEN(j)  (2304 + 64 * (j))
#define XB_TOP      3328
#define XB_TOPGEN   3392
#define XCD_BAR_WORDS 3456
#define XB_SPIN_CAP (1u << 22)
__device__ __forceinline__ unsigned xb_ld(unsigned* p)              { return __hip_atomic_load(p, __ATOMIC_RELAXED, __HIP_MEMORY_SCOPE_AGENT); }
__device__ __forceinline__ unsigned xb_add(unsigned* p, unsigned v) { return __hip_atomic_fetch_add(p, v, __ATOMIC_RELAXED, __HIP_MEMORY_SCOPE_AGENT); }
__device__ __forceinline__ unsigned xb_xcc_id() { return (unsigned)__builtin_amdgcn_s_getreg((3 << 11) | 20) & 0xFu; }
#define XB_SPIN(cond, bar) do { unsigned _sp = 0; while (cond) { __builtin_amdgcn_s_sleep(1); \
    if ((++_sp & 255u) == 0u) { if (xb_ld(&(bar)[XB_TMO])) break; if (_sp > XB_SPIN_CAP) { atomicAdd(&(bar)[XB_TMO], 1u); break; } } } } while (0)
struct XcdBarrier { unsigned* bar; unsigned x; volatile LAS unsigned* st; };
__device__ __forceinline__ void xcd_barrier_complete(unsigned* bar, unsigned x, unsigned& nloc, unsigned& nx) {
    const unsigned G = gridDim.x * gridDim.y * gridDim.z;
    unsigned sum, cnt, mine, sp = 0u;
    for (;;) {
        sum = 0u; cnt = 0u; mine = 0u;
#pragma unroll
        for (unsigned j = 0; j < 16; ++j) { const unsigned c = xb_ld(&bar[XB_XCNT(j)]); sum += c; cnt += (c > 0u) ? 1u : 0u; mine = (j == x) ? c : mine; }
        if (sum == G) break;
        __builtin_amdgcn_s_sleep(1);
        if ((++sp & 255u) == 0u) { if (xb_ld(&bar[XB_TMO])) break; if (sp > XB_SPIN_CAP) { atomicAdd(&bar[XB_TMO], 1u); break; } }
    }
    nloc = mine > 0u ? mine : 1u; nx = cnt > 0u ? cnt : 1u;
}
__device__ __forceinline__ void xcd_barrier(const XcdBarrier& b) {
    asm volatile("s_waitcnt vmcnt(0)" ::: "memory");
    __syncthreads();
    if (threadIdx.x == 0) {
        unsigned* bar = b.bar;
        __builtin_amdgcn_s_waitcnt(0);
        unsigned nloc = b.st[0], nx = b.st[1];
        if (nloc == 0u) { xcd_barrier_complete(bar, b.x, nloc, nx); b.st[0] = nloc; b.st[1] = nx; }
        const unsigned old = xb_add(&bar[XB_XSUB(b.x)], 1u);
        const unsigned gen = old / nloc;
        if (old + 1u == (gen + 1u) * nloc) {
            __builtin_amdgcn_fence(__ATOMIC_RELEASE, "agent");
            asm volatile("s_waitcnt vmcnt(0)" ::: "memory");
            const unsigned og = xb_add(&bar[XB_TOP], 1u);
            const unsigned tg = og / nx;
            if (og + 1u == (tg + 1u) * nx) xb_add(&bar[XB_TOPGEN], 1u);
            else XB_SPIN(xb_ld(&bar[XB_TOPGEN]) == tg, bar);
            __builtin_amdgcn_fence(__ATOMIC_ACQUIRE, "agent");
            xb_add(&bar[XB_XGEN(b.x)], 1u);
            asm volatile("s_waitcnt vmcnt(0)" ::: "memory");
        } else {
            XB_SPIN(xb_ld(&bar[XB_XGEN(b.x)]) == gen, bar);
            __builtin_amdgcn_fence(__ATOMIC_ACQUIRE, "agent");
            asm volatile("s_waitcnt vmcnt(0)" ::: "memory");
        }
    }
    __syncthreads();
}

enum { K_WEIGHTS = 0, K_NORM, K_G_SWIGLU, K_G_RESID, K_G_STORE, K_LA_PREP, K_LA_SCAN, K_LA_POST, K_ATTN, K_CONV, K_SCAN1, K_SCAN2, K_FINAL };
constexpr int NPH = 1 + (7 + 5) + (7 + 5) + (7 + 3) + (7 + 6) + 1;

__device__ __forceinline__ const float* inp(const Params& p, int k) { asm volatile("" : "+s"(k)); return (const float*)(const GAS float*)p.in[k]; }

__global__ void __launch_bounds__(512, 2) fwd_kernel(Params p) {
    extern __shared__ __attribute__((aligned(16))) unsigned char lds_raw[];
    unsigned char* lds = lds_raw;
    LAS unsigned char* lds3 = (LAS unsigned char*)lds_raw;
    const int wid_root = __builtin_amdgcn_readfirstlane(threadIdx.x >> 6);
    if (threadIdx.x < 2) ((volatile LAS unsigned*)(lds3 + LDS_BAR))[threadIdx.x] = 0u;
    if (threadIdx.x == 0) (void)xb_add(&((unsigned*)p.ws)[XB_XCNT(xb_xcc_id())], 1u);
    __syncthreads();
    for (int ph = p.ph_lo; ph < p.ph_hi; ++ph) {
        int wq = wid_root; asm volatile("" : "+s"(wq));
        int lane_; asm volatile("v_mbcnt_lo_u32_b32 %0, -1, 0\n\tv_mbcnt_hi_u32_b32 %0, -1, %0" : "=v"(lane_));
        const int tid = wq * 64 + lane_;
        int bid = blockIdx.x; asm volatile("" : "+s"(bid));
        int G = gridDim.x; asm volatile("" : "+s"(G));
        unsigned char* ws = p.ws; asm volatile("" : "+s"(ws)); ws = (unsigned char*)(GAS unsigned char*)ws;
        float* xout = p.out; asm volatile("" : "+s"(xout)); xout = (float*)(GAS float*)xout;
        bf16_t* Hb = (bf16_t*)(ws + WS_H);
        bf16_t* R1 = (bf16_t*)(ws + WS_R1);
        bf16_t* XR = (bf16_t*)(ws + WS_XR);
        float* SSP = (float*)(ws + WS_SSP);
        float* RSTD = (float*)(ws + WS_RSTD);
        int kind = K_FINAL, L = 0, sub = 0;
        if (ph == 0) kind = K_WEIGHTS;
        else { int q = ph - 1;
            for (int l = 0; l < 4; ++l) { const int cn = (l == 0 || l == 1) ? 12 : (l == 2 ? 10 : 13); if (q < cn) { L = l; sub = q; kind = -1; break; } q -= cn; } }
        int ffn = 0, nidx = 0, mix = -1, msub = 0;
        if (kind == -1) {
            const int mc = (L == 2) ? 3 : (L == 3 ? 6 : 5);
            if (sub == 0) { kind = K_NORM; nidx = 0; }
            else if (sub == 1) { kind = K_G_SWIGLU; ffn = 2 * L; }
            else if (sub == 2) { kind = K_G_RESID; ffn = 2 * L; }
            else if (sub == 3) { kind = K_NORM; nidx = 1; }
            else if (sub < 4 + mc) { mix = L; msub = sub - 4;
                if (L == 0 || L == 1) kind = msub == 0 ? K_G_STORE : msub == 1 ? K_LA_PREP : msub == 2 ? K_LA_SCAN : msub == 3 ? K_LA_POST : K_G_RESID;
                else if (L == 2) kind = msub == 0 ? K_G_STORE : msub == 1 ? K_ATTN : K_G_RESID;
                else kind = msub == 0 ? K_G_STORE : msub == 1 ? K_CONV : msub == 2 ? K_G_STORE : msub == 3 ? K_SCAN1 : msub == 4 ? K_SCAN2 : K_G_RESID; }
            else { const int s2 = sub - 4 - mc; if (s2 == 0) { kind = K_NORM; nidx = 2; } else if (s2 == 1) { kind = K_G_SWIGLU; ffn = 2 * L + 1; } else { kind = K_G_RESID; ffn = 2 * L + 1; } }
        }
        if (kind == K_NORM) continue;
        switch (kind) {
        case K_WEIGHTS: weights_phase(tid, bid, G, p, ws, lds); first_phase(tid, bid, G, inp(p, 0), XR, SSP); break;
        case K_NORM: rstd_phase(tid, bid, G, SSP, RSTD); break;
        case K_FINAL: final_phase(tid, bid, G, XR, SSP, xout, inp(p, 4)); break;
        case K_G_SWIGLU: {
            pg8::Gemm g{XR, (const bf16_t*)(ws + WS_W + ffn * FFN_STRIDE), M, 2 * FF, DM, DM, 0};
            pg8::StaticOrder S; S.init(M, 2 * FF, G, bid);
            pg8::EpiSwiGLU E{R1, SSP};
            pg8::gemm_phase<pg8::EpiSwiGLU>(tid, lds3, g, S, E);
        } break;
        case K_G_RESID: {
            pg8::Gemm g; float scale;
            if (mix < 0) { g = pg8::Gemm{R1, (const bf16_t*)(ws + WS_W + ffn * FFN_STRIDE + WD_OFF), M, DM, FF, FF, 0}; scale = 0.5f; }
            else { const size_t wo = mix == 0 ? WS_HG_OUT : mix == 1 ? WS_GL_OUT : mix == 2 ? WS_AT_OUT : WS_LR_OUT; g = pg8::Gemm{Hb, (const bf16_t*)(ws + wo), M, DM, DM, DM, 0}; scale = 1.0f; }
            pg8::StaticOrder S; S.init(M, DM, G, bid);
            pg8::EpiResid E{XR, scale, SSP, nullptr};
            pg8::gemm_phase<pg8::EpiResid>(tid, lds3, g, S, E);
        } break;
        case K_G_STORE: {
            const bool gate = (mix == 3 && msub == 2);
            const int N = mix == 0 ? 4096 : mix == 1 ? 3584 : mix == 2 ? 3072 : 2048;
            const size_t wi = mix == 0 ? WS_HG_IN : mix == 1 ? WS_GL_IN : mix == 2 ? WS_AT_IN : (gate ? WS_LR_GATE : WS_LR_IN);
            pg8::Gemm g{gate ? Hb : XR, (const bf16_t*)(ws + wi), M, N, gate ? 256 : DM, DM, gate ? 2 : 0};
            pg8::StaticOrder S; S.init(M, N, G, bid);
            pg8::EpiStore E{gate ? R1 + (size_t)M * 2048 : R1, N, gate ? (const float*)nullptr : (const float*)SSP};
            pg8::gemm_phase<pg8::EpiStore>(tid, lds3, g, S, E);
        } break;
        case K_LA_PREP:
            if (mix == 0) la_prep<0>(tid, bid, G, lds, R1, inp(p, 6), L, nullptr, (bf16_t*)(ws + WS_R2), (float*)(ws + WS_DL));
            else la_prep<1>(tid, bid, G, lds, R1, nullptr, L, inp(p, 12), (bf16_t*)(ws + WS_R2), (float*)(ws + WS_DL));
            break;
        case K_LA_SCAN:
            if (mix == 0) la_scan<0>(tid, bid, G, lds, R1, (const bf16_t*)(ws + WS_R2), (const float*)(ws + WS_DL), Hb);
            else la_scan<1>(tid, bid, G, lds, R1, (const bf16_t*)(ws + WS_R2), (const float*)(ws + WS_DL), Hb);
            break;
        case K_LA_POST:
            if (mix == 0) la_post<0>(tid, bid, G, Hb, R1, inp(p, 7)); else la_post<1>(tid, bid, G, Hb, R1, inp(p, 13));
            break;
        case K_ATTN: attn_phase(tid, bid, G, lds, R1, inp(p, 16), Hb); break;
        case K_CONV: conv_phase(tid, bid, G, R1, inp(p, 19), inp(p, 20), Hb); break;
        case K_SCAN1: lru_scan1(tid, bid, G, R1 + (size_t)M * 2048, Hb, inp(p, 22), inp(p, 24), inp(p, 25), (float*)(ws + WS_R2), (float*)(ws + WS_R2 + 4 * MiB)); break;
        case K_SCAN2: lru_scan2(tid, bid, G, R1 + (size_t)M * 2048, (const float*)(ws + WS_R2), (const float*)(ws + WS_R2 + 4 * MiB), R1, Hb); break;
        default: break;
        }
        if (ph + 1 < p.ph_hi) {
            if (ph == p.ph_lo) cg::this_grid().sync();
            else { XcdBarrier xb; xb.bar = (unsigned*)ws; xb.x = xb_xcc_id(); xb.st = (volatile LAS unsigned*)(lds3 + LDS_BAR); xcd_barrier(xb); }
        }
    }
}

extern "C" void kernel_launch(void* const* d_in, const int* in_sizes, int n_in, void* d_out, int out_size, void* d_ws, size_t ws_size, hipStream_t stream) {
    static int grid = 0;
    if (grid == 0) {
        if (n_in != 27 || out_size != M * DM || ws_size < WS_END) { fprintf(stderr, "kernel_launch: unexpected sizes (n_in %d, out %d, ws %zu; need ws >= %zu); nothing launched\n", n_in, out_size, ws_size, (size_t)WS_END); grid = -1; return; }
        int dev = 0, cus = 0, per_cu = 0;
        if (hipGetDevice(&dev) != hipSuccess || hipDeviceGetAttribute(&cus, hipDeviceAttributeMultiprocessorCount, dev) != hipSuccess) { grid = -1; return; }
        if (hipFuncSetAttribute((const void*)fwd_kernel, hipFuncAttributeMaxDynamicSharedMemorySize, LDS_BYTES) != hipSuccess) { fprintf(stderr, "kernel_launch: hipFuncSetAttribute failed\n"); grid = -1; return; }
        if (hipOccupancyMaxActiveBlocksPerMultiprocessor(&per_cu, (const void*)fwd_kernel, 512, LDS_BYTES) != hipSuccess || per_cu < 1) { fprintf(stderr, "kernel_launch: occupancy query says %d blocks per CU\n", per_cu); per_cu = 1; }
        (void)hipGetLastError();
        grid = cus;
    }
    if (grid < 0) return;
    if (hipMemsetAsync(d_ws, 0, 16384, stream) != hipSuccess) { fprintf(stderr, "kernel_launch: memset of the barrier words failed\n"); return; }
    Params p{};
    for (int i = 0; i < 27; ++i) p.in[i] = (const float*)d_in[i];
    p.out = (float*)d_out; p.ws = (unsigned char*)d_ws;
#if ONE_LAUNCH
    p.ph_lo = 0; p.ph_hi = NPH;
    void* args[] = {&p};
    hipError_t e = hipLaunchCooperativeKernel((const void*)fwd_kernel, dim3(grid), dim3(512), args, LDS_BYTES, stream);
    if (e != hipSuccess) fprintf(stderr, "kernel_launch: cooperative launch failed: %s (grid %d)\n", hipGetErrorString(e), grid);
#else
    for (int ph = 0; ph < NPH; ++ph) { p.ph_lo = ph; p.ph_hi = ph + 1; hipLaunchKernelGGL(fwd_kernel, dim3(grid), dim3(512), LDS_BYTES, stream, p); }
#endif
}
```
